# Optimizing an MI355X kernel written in HIP

```python
import math
import jax, jax.numpy as jnp
from jax import lax
import numpy as np

D_MODEL = 2048
BATCH = 4
SEQ = 2048
DEPTH = 2
DEC_BATCH = 128
DEC_SEQ = 4
PAST_LEN = 16384
PAGE_SIZE = 128

GDN_HEADS = 6
GDN_DK = 128
GDN_DV = 128
MLSTM_HEADS = 6
MLSTM_DK = 128
MLSTM_DV = 128
LRU_WIDTH = 512
LRU_BLOCKS = 8
LRU_C = 8.0
CONV_W = 4
CHUNK = 64
D_FF = 5632
ALPHA = (2 * DEPTH) ** 0.25
BETA_INIT = (8 * DEPTH) ** -0.25
NORM_EPS = 1e-6

GDN_QK = GDN_HEADS * GDN_DK
GDN_V = GDN_HEADS * GDN_DV
ML_QK = MLSTM_HEADS * MLSTM_DK
ML_V = MLSTM_HEADS * MLSTM_DV
GDN_CONV_CH = 2 * GDN_QK + GDN_V
D_MIX = GDN_V + ML_V + LRU_WIDTH
IN_SIZES = (GDN_CONV_CH, GDN_V, GDN_HEADS, GDN_HEADS,
            ML_QK, ML_QK, ML_V, ML_V, MLSTM_HEADS, MLSTM_HEADS,
            LRU_WIDTH, LRU_WIDTH)
D_IN = sum(IN_SIZES)
IN_SPLITS = tuple(int(s) for s in np.cumsum(IN_SIZES)[:-1])

kernel_name = 'hybrid_gdn_mlstm_rglru_macaron_deepnorm_step'


def _layernorm(x, g, b):
    xf = x.astype(jnp.float32)
    mu = jnp.mean(xf, -1, keepdims=True)
    var = jnp.mean(jnp.square(xf - mu), -1, keepdims=True)
    return ((xf - mu) * lax.rsqrt(var + NORM_EPS) * g + b).astype(x.dtype)


def _rmsnorm(x, g):
    xf = x.astype(jnp.float32)
    return xf * lax.rsqrt(jnp.mean(xf * xf, -1, keepdims=True) + NORM_EPS) * g


def _l2norm(x):
    xf = x.astype(jnp.float32)
    return xf * lax.rsqrt(jnp.sum(xf * xf, -1, keepdims=True) + NORM_EPS)


def _swiglu(x, wg, wu, wd):
    return (jax.nn.silu(x @ wg) * (x @ wu)) @ wd


def _causal_conv(x, buf, w):
    T = x.shape[1]
    xp = jnp.concatenate([buf.astype(x.dtype), x], axis=1)
    y = sum(xp[:, k:k + T] * w[k] for k in range(CONV_W))
    return y, xp[:, xp.shape[1] - (CONV_W - 1):]


def _to_chunks(a, C):
    B, T = a.shape[:2]
    a = a.reshape((B, T // C, C) + a.shape[2:])
    a = jnp.moveaxis(a, 3, 2)
    return jnp.moveaxis(a, 1, 0)


def _from_chunks(o):
    N, B, H, C, D = o.shape
    return jnp.moveaxis(jnp.moveaxis(o, 0, 1), 2, 3).reshape(B, N * C, H, D)


def _gated_delta(q, k, v, g, beta, S0):
    f32 = jnp.float32
    T = q.shape[1]
    DV = v.shape[-1]
    C = math.gcd(T, CHUNK)
    qc, kc, vc = _to_chunks(q.astype(f32), C), _to_chunks(k.astype(f32), C), _to_chunks(v.astype(f32), C)
    gc, bc = _to_chunks(g.astype(f32), C), _to_chunks(beta.astype(f32), C)
    G = jnp.cumsum(gc, axis=-1)
    causal = jnp.tril(jnp.ones((C, C), bool))
    strict = jnp.tril(jnp.ones((C, C), bool), -1)
    decay = jnp.exp(jnp.where(causal, G[..., :, None] - G[..., None, :], -jnp.inf))
    kk = jnp.einsum('nbhid,nbhjd->nbhij', kc, kc)
    M = jnp.where(strict, bc[..., :, None] * kk * decay, 0.0) + jnp.eye(C, dtype=f32)
    rhs = jnp.concatenate([bc[..., None] * vc, (bc * jnp.exp(G))[..., None] * kc], axis=-1)
    sol = lax.linalg.triangular_solve(M, rhs, left_side=True, lower=True, unit_diagonal=True)
    Uv, Wk = sol[..., :DV], sol[..., DV:]
    qk = jnp.where(causal, jnp.einsum('nbhid,nbhjd->nbhij', qc, kc) * decay, 0.0)
    q_dec = qc * jnp.exp(G)[..., None]
    k_tail = kc * jnp.exp(G[..., -1:] - G)[..., None]
    g_tot = jnp.exp(G[..., -1])

    def step(S, xs):
        uv, wk, qk_n, qd, kt, gt = xs
        U = uv - jnp.einsum('bhck,bhkv->bhcv', wk, S)
        o = jnp.einsum('bhck,bhkv->bhcv', qd, S) + jnp.einsum('bhij,bhjv->bhiv', qk_n, U)
        S = gt[..., None, None] * S + jnp.einsum('bhck,bhcv->bhkv', kt, U)
        return S, o

    S, o = lax.scan(step, S0.astype(f32), (Uv, Wk, qk, q_dec, k_tail, g_tot))
    return _from_chunks(o), S


def _mlstm(q, k, v, i_pre, logf, C0, n0, m0):
    f32 = jnp.float32
    T = q.shape[1]
    C = math.gcd(T, CHUNK)
    qc, kc, vc = _to_chunks(q.astype(f32), C), _to_chunks(k.astype(f32), C), _to_chunks(v.astype(f32), C)
    ic, fc = _to_chunks(i_pre.astype(f32), C), _to_chunks(logf.astype(f32), C)
    b = jnp.cumsum(fc, axis=-1)
    causal = jnp.tril(jnp.ones((C, C), bool))
    D = jnp.where(causal, b[..., :, None] - b[..., None, :] + ic[..., None, :], -jnp.inf)
    Dmax = jnp.max(D, axis=-1)

    def step(carry, xs):
        Cm, n, m = carry
        q_n, k_n, v_n, b_n, i_n, D_n, Dm_n = xs
        m_t = jnp.maximum(b_n + m[..., None], Dm_n)
        inter = jnp.exp(b_n + m[..., None] - m_t)
        Sw = jnp.exp(D_n - m_t[..., None]) * jnp.einsum('bhik,bhjk->bhij', q_n, k_n)
        num = inter[..., None] * jnp.einsum('bhck,bhkv->bhcv', q_n, Cm) + jnp.einsum('bhij,bhjv->bhiv', Sw, v_n)
        den = inter * jnp.einsum('bhck,bhk->bhc', q_n, n) + jnp.sum(Sw, -1)
        h = num / jnp.maximum(jnp.abs(den), jnp.exp(-m_t))[..., None]
        m_new = m_t[..., -1]
        wk = jnp.exp(b_n[..., -1:] - b_n + i_n - m_new[..., None])
        dec = jnp.exp(b_n[..., -1] + m - m_new)
        Cm = dec[..., None, None] * Cm + jnp.einsum('bhc,bhck,bhcv->bhkv', wk, k_n, v_n)
        n = dec[..., None] * n + jnp.einsum('bhc,bhck->bhk', wk, k_n)
        return (Cm, n, m_new), h

    carry0 = (C0.astype(f32), n0.astype(f32), m0.astype(f32))
    (Cm, n, m), h = lax.scan(step, carry0, (qc, kc, vc, b, ic, D, Dmax))
    return _from_chunks(h), Cm, n, m


def _rglru(x, h0, wr, br, wi, bi, lam):
    f32 = jnp.float32
    B, T, W = x.shape
    xb = x.reshape(B, T, LRU_BLOCKS, W // LRU_BLOCKS)
    r = jax.nn.sigmoid(jnp.einsum('btnd,nde->btne', xb, wr).reshape(B, T, W) + br)
    ig = jax.nn.sigmoid(jnp.einsum('btnd,nde->btne', xb, wi).reshape(B, T, W) + bi)
    log_a = (-LRU_C * r * jax.nn.softplus(-lam)).astype(f32)
    a = jnp.exp(log_a)
    u = jnp.sqrt(-jnp.expm1(2.0 * log_a)) * (ig * x).astype(f32)
    u = u.at[:, 0].add(a[:, 0] * h0.astype(f32))

    def comb(l, rr):
        a1, b1 = l
        a2, b2 = rr
        return a1 * a2, a2 * b1 + b2

    _, h = lax.associative_scan(comb, (a, u), axis=1)
    return h, h[:, -1]


def _layer(x, gS, gconv, mC, mn, mm, lh, lconv,
           ffn1_wg, ffn1_wu, ffn1_wd, ln_g, ln_b, w_in,
           gdn_conv_w, gdn_A_log, gdn_dt_bias, gdn_norm_w,
           mlstm_i_bias, mlstm_f_bias, mlstm_norm_w,
           lru_conv_w, lru_conv_b, lru_wr, lru_br, lru_wi, lru_bi, lru_lambda,
           w_out, ffn2_wg, ffn2_wu, ffn2_wd):
    B, T, _ = x.shape
    f32 = jnp.float32
    x = _layernorm(ALPHA * x + 0.5 * _swiglu(x, ffn1_wg, ffn1_wu, ffn1_wd), ln_g[0], ln_b[0])
    u = x @ w_in
    (g_qkv, g_z, g_b, g_a, m_q, m_k, m_v, m_o, m_i, m_f, l_x, l_y) = jnp.split(u, IN_SPLITS, axis=-1)
    c_qkv, gconv_new = _causal_conv(g_qkv, gconv, gdn_conv_w)
    c_qkv = jax.nn.silu(c_qkv)
    gq, gk, gv = jnp.split(c_qkv, [GDN_QK, 2 * GDN_QK], axis=-1)
    gq = _l2norm(gq.reshape(B, T, GDN_HEADS, GDN_DK)) * GDN_DK ** -0.5
    gk = _l2norm(gk.reshape(B, T, GDN_HEADS, GDN_DK))
    gv = gv.reshape(B, T, GDN_HEADS, GDN_DV)
    beta = jax.nn.sigmoid(g_b.astype(f32))
    g = -jnp.exp(gdn_A_log.astype(f32)) * jax.nn.softplus(g_a.astype(f32) + gdn_dt_bias)
    o_g, gS_new = _gated_delta(gq, gk, gv, g, beta, gS)
    o_g = _rmsnorm(o_g, gdn_norm_w) * jax.nn.silu(g_z.reshape(B, T, GDN_HEADS, GDN_DV).astype(f32))
    mq = m_q.reshape(B, T, MLSTM_HEADS, MLSTM_DK)
    mk = m_k.reshape(B, T, MLSTM_HEADS, MLSTM_DK) * MLSTM_DK ** -0.5
    mv = m_v.reshape(B, T, MLSTM_HEADS, MLSTM_DV)
    i_pre = m_i.astype(f32) + mlstm_i_bias
    logf = jax.nn.log_sigmoid(m_f.astype(f32) + mlstm_f_bias)
    h_m, mC_new, mn_new, mm_new = _mlstm(mq, mk, mv, i_pre, logf, mC, mn, mm)
    h_m = _rmsnorm(h_m, mlstm_norm_w.reshape(MLSTM_HEADS, MLSTM_DV)) * \
        jax.nn.sigmoid(m_o.reshape(B, T, MLSTM_HEADS, MLSTM_DV).astype(f32))
    c_x, lconv_new = _causal_conv(l_x, lconv, lru_conv_w)
    c_x = c_x + lru_conv_b
    h_l, lh_new = _rglru(c_x, lh, lru_wr, lru_br, lru_wi, lru_bi, lru_lambda)
    o_l = h_l * jax.nn.gelu(l_y.astype(f32))
    mix = jnp.concatenate([o_g.reshape(B, T, GDN_V).astype(x.dtype),
                           h_m.reshape(B, T, ML_V).astype(x.dtype),
                           o_l.astype(x.dtype)], axis=-1) @ w_out
    x = _layernorm(ALPHA * x + mix, ln_g[1], ln_b[1])
    x = _layernorm(ALPHA * x + 0.5 * _swiglu(x, ffn2_wg, ffn2_wu, ffn2_wd), ln_g[2], ln_b[2])
    return x, (gS_new, gconv_new, mC_new, mn_new, mm_new, lh_new, lconv_new)


def _trunk(x, gS, gconv, mC, mn, mm, lh, lconv, weights):
    per_layer = []
    for d in range(DEPTH):
        x, st = _layer(x, gS[d], gconv[d], mC[d], mn[d], mm[d], lh[d], lconv[d],
                       *[w[d] for w in weights])
        per_layer.append(st)
    stacked = [jnp.stack(s) for s in zip(*per_layer)]
    return x, stacked


def setup_inputs(seed: int = 0) -> dict:
    key = jax.random.key(seed)
    ks = iter(jax.random.split(key, 48))
    nrm = lambda shape, s: jax.random.normal(next(ks), shape, jnp.float32) * s
    f32 = jnp.float32
    inp = {}
    inp['x_prompt'] = nrm((BATCH, SEQ, D_MODEL), 1.0)
    inp['x_sample'] = nrm((DEC_BATCH, DEC_SEQ, D_MODEL), 1.0)
    inp['state_gdn_S'] = nrm((DEPTH, DEC_BATCH, GDN_HEADS, GDN_DK, GDN_DV), 0.3)
    inp['state_gdn_conv'] = nrm((DEPTH, DEC_BATCH, CONV_W - 1, GDN_CONV_CH), 1.0)
    inp['state_mlstm_C'] = nrm((DEPTH, DEC_BATCH, MLSTM_HEADS, MLSTM_DK, MLSTM_DV), 0.3)
    inp['state_mlstm_n'] = nrm((DEPTH, DEC_BATCH, MLSTM_HEADS, MLSTM_DK), 0.3)
    inp['state_mlstm_m'] = nrm((DEPTH, DEC_BATCH, MLSTM_HEADS), 1.0)
    inp['state_lru_h'] = nrm((DEPTH, DEC_BATCH, LRU_WIDTH), 0.5)
    inp['state_lru_conv'] = nrm((DEPTH, DEC_BATCH, CONV_W - 1, LRU_WIDTH), 1.0)
    inp['ffn1_wg'] = nrm((DEPTH, D_MODEL, D_FF), D_MODEL ** -0.5)
    inp['ffn1_wu'] = nrm((DEPTH, D_MODEL, D_FF), D_MODEL ** -0.5)
    inp['ffn1_wd'] = nrm((DEPTH, D_FF, D_MODEL), D_FF ** -0.5 * BETA_INIT)
    inp['ln_g'] = 1.0 + nrm((DEPTH, 3, D_MODEL), 0.02)
    inp['ln_b'] = nrm((DEPTH, 3, D_MODEL), 0.02)
    inp['w_in'] = nrm((DEPTH, D_MODEL, D_IN), D_MODEL ** -0.5)
    inp['gdn_conv_w'] = nrm((DEPTH, CONV_W, GDN_CONV_CH), CONV_W ** -0.5)
    inp['gdn_A_log'] = jnp.log(jax.random.uniform(next(ks), (DEPTH, GDN_HEADS), f32, 1.0, 16.0))
    dt = jnp.exp(jax.random.uniform(next(ks), (DEPTH, GDN_HEADS), f32, math.log(1e-3), math.log(1e-1)))
    inp['gdn_dt_bias'] = dt + jnp.log(-jnp.expm1(-dt))
    inp['gdn_norm_w'] = 1.0 + nrm((DEPTH, GDN_DV), 0.02)
    inp['mlstm_i_bias'] = nrm((DEPTH, MLSTM_HEADS), 0.1)
    inp['mlstm_f_bias'] = jnp.linspace(3.0, 6.0, MLSTM_HEADS, dtype=f32)[None] + nrm((DEPTH, MLSTM_HEADS), 0.1)
    inp['mlstm_norm_w'] = 1.0 + nrm((DEPTH, ML_V), 0.02)
    inp['lru_conv_w'] = nrm((DEPTH, CONV_W, LRU_WIDTH), CONV_W ** -0.5)
    inp['lru_conv_b'] = nrm((DEPTH, LRU_WIDTH), 0.02)
    blk = LRU_WIDTH // LRU_BLOCKS
    inp['lru_wr'] = nrm((DEPTH, LRU_BLOCKS, blk, blk), blk ** -0.5)
    inp['lru_br'] = nrm((DEPTH, LRU_WIDTH), 0.02)
    inp['lru_wi'] = nrm((DEPTH, LRU_BLOCKS, blk, blk), blk ** -0.5)
    inp['lru_bi'] = nrm((DEPTH, LRU_WIDTH), 0.02)
    s = jax.random.uniform(next(ks), (DEPTH, LRU_WIDTH), f32, 0.9 ** (1.0 / LRU_C), 0.999 ** (1.0 / LRU_C))
    inp['lru_lambda'] = jnp.log(s) - jnp.log1p(-s)
    inp['w_out'] = nrm((DEPTH, D_MIX, D_MODEL), D_MIX ** -0.5 * BETA_INIT)
    inp['ffn2_wg'] = nrm((DEPTH, D_MODEL, D_FF), D_MODEL ** -0.5)
    inp['ffn2_wu'] = nrm((DEPTH, D_MODEL, D_FF), D_MODEL ** -0.5)
    inp['ffn2_wd'] = nrm((DEPTH, D_FF, D_MODEL), D_FF ** -0.5 * BETA_INIT)
    return inp


def reference(x_prompt, x_sample, state_gdn_S, state_gdn_conv, state_mlstm_C, state_mlstm_n,
              state_mlstm_m, state_lru_h, state_lru_conv,
              ffn1_wg, ffn1_wu, ffn1_wd, ln_g, ln_b, w_in,
              gdn_conv_w, gdn_A_log, gdn_dt_bias, gdn_norm_w,
              mlstm_i_bias, mlstm_f_bias, mlstm_norm_w,
              lru_conv_w, lru_conv_b, lru_wr, lru_br, lru_wi, lru_bi, lru_lambda,
              w_out, ffn2_wg, ffn2_wu, ffn2_wd):
    weights = (ffn1_wg, ffn1_wu, ffn1_wd, ln_g, ln_b, w_in,
               gdn_conv_w, gdn_A_log, gdn_dt_bias, gdn_norm_w,
               mlstm_i_bias, mlstm_f_bias, mlstm_norm_w,
               lru_conv_w, lru_conv_b, lru_wr, lru_br, lru_wi, lru_bi, lru_lambda,
               w_out, ffn2_wg, ffn2_wu, ffn2_wd)
    nb = x_prompt.shape[0]
    zero_states = [jnp.zeros((DEPTH, nb) + s.shape[2:], jnp.float32)
                   for s in (state_gdn_S, state_gdn_conv, state_mlstm_C, state_mlstm_n,
                             state_mlstm_m, state_lru_h, state_lru_conv)]
    y_prompt, (p_gS, p_gconv, p_mC, p_mn, p_mm, p_lh, p_lconv) = _trunk(x_prompt, *zero_states, weights)
    y_sample, (s_gS, s_gconv, s_mC, s_mn, s_mm, s_lh, s_lconv) = _trunk(
        x_sample, state_gdn_S, state_gdn_conv, state_mlstm_C, state_mlstm_n,
        state_mlstm_m, state_lru_h, state_lru_conv, weights)
    return (y_prompt, y_sample,
            p_gS, p_gconv, p_mC, p_mn, p_mm, p_lh, p_lconv,
            s_gS, s_gconv, s_mC, s_mn, s_mm, s_lh, s_lconv)
```

```cpp
#include <hip/hip_runtime.h>
#include <hip/hip_cooperative_groups.h>
#include <cstdio>
namespace cg = cooperative_groups;
#ifndef MULTI_LAUNCH
#define MULTI_LAUNCH 1
#endif
namespace pg8 {
#define PG8_LAS __attribute__((address_space(3)))
typedef unsigned short bf16_t;
typedef short bf16x8 __attribute__((ext_vector_type(8)));
typedef float f32x4 __attribute__((ext_vector_type(4)));
typedef unsigned u32x4 __attribute__((ext_vector_type(4)));
constexpr int BM = 256, BK = 64, HALF = 128, HTB = HALF * BK * 2  , STAGE_BYTES = 8 * HTB, NXCD = 8, WGM = 8;

__host__ __device__ __forceinline__ int lds_byte(int r, int c) { const int st = (r >> 4) * 2 + (c >> 5), rr = r & 15, cc = c & 31, ob = rr * 64 + cc * 2; return st * 1024 + (ob ^ (((ob >> 9) & 1) << 5)); }
__host__ __device__ __forceinline__ void stage_rc(int b, int& R, int& C) { const int st = b / 1024, sb = b % 1024, swz = sb ^ (((sb >> 9) & 1) << 5); R = (st >> 1) * 16 + swz / 64; C = (st & 1) * 32 + (swz % 64) / 2; }
__host__ __device__ __forceinline__ int perm32(int rho) { const int n = rho >> 4, i = rho & 15; return 8 * (i >> 2) + 4 * n + (i & 3); }

struct Unit { int pm, pn; };
struct Gemm { const bf16_t* A; const bf16_t* Bt; int M, N, K; };

struct StaticOrder {
    int nM, nN, nwg, G, c;
    __host__ __device__ void init(int M, int N, int G_, int c_) { nM = M / BM; nN = N / BM; nwg = nM * nN; G = G_; c = c_; }
    __host__ __device__ bool next(int i, Unit& u) const {
        const long L = (long)i * G + c; if (L >= nwg) return false;
        int wgid = (int)L; { const int q = nwg / NXCD, r = nwg % NXCD, xcd = wgid % NXCD, off = wgid / NXCD; wgid = (xcd < r ? xcd * (q + 1) : r * (q + 1) + (xcd - r) * q) + off; }
        const int nig = WGM * nN, gid = wgid / nig, fm = gid * WGM, gsz = (nM - fm) < WGM ? (nM - fm) : WGM;
        u.pm = fm + ((wgid % nig) % gsz); u.pn = (wgid % nig) / gsz; return true;
    }
    __device__ __forceinline__ void a_ready(const Unit&) const {}
    __device__ __forceinline__ void done(const Unit&) const {}
};
__device__ __forceinline__ unsigned cvt_pk_bf16(float lo, float hi) { unsigned r; asm volatile("v_cvt_pk_bf16_f32 %0, %1, %2" : "=v"(r) : "v"(lo), "v"(hi)); return r; }
typedef float f32x2 __attribute__((ext_vector_type(2)));
struct EpiF32 {
    static constexpr bool PERM = false, AFTER_DRAIN = false;
    float* C; int ldc; const float* bias;
    __device__ __forceinline__ void operator()(const f32x4 (&acc)[2][2][4][2], const Unit& u, int wr, int wc, int fr, int fq) const {
        const int row0 = u.pm * BM + wr * 64 + fr, col0 = u.pn * BM + wc * 32 + 4 * fq;
        f32x4 bv[2][2];
#pragma unroll
        for (int bj = 0; bj < 2; ++bj)
#pragma unroll
            for (int n = 0; n < 2; ++n) bv[bj][n] = bias ? *(const f32x4*)(bias + col0 + bj * HALF + n * 16) : (f32x4){0.f, 0.f, 0.f, 0.f};
#pragma unroll
        for (int ai = 0; ai < 2; ++ai)
#pragma unroll
            for (int m = 0; m < 4; ++m) { float* rowp = C + (size_t)(row0 + ai * HALF + m * 16) * ldc + col0;
#pragma unroll
                for (int bj = 0; bj < 2; ++bj)
#pragma unroll
                    for (int n = 0; n < 2; ++n) *(f32x4*)(rowp + bj * HALF + n * 16) = acc[ai][bj][m][n] + bv[bj][n]; }
    }
};
template <class Epi, class Sched, bool STAMP = false>
__device__ __forceinline__ void gemm_phase(PG8_LAS unsigned char* lds, const Gemm g, const Sched& S, const Epi& E, unsigned long long* stamps) {
    int tid_ = threadIdx.x; asm volatile("" : "+v"(tid_));
    int K_ = g.K; asm volatile("" : "+s"(K_));
    const int tid = tid_, wid = __builtin_amdgcn_readfirstlane(tid >> 6), lane = tid & 63, wr = wid >> 2, wc = wid & 3, fr = lane & 15, fq = lane >> 4;
    const int K = K_, nt = K / BK;
    int ts_lo = 0, ts_hi = 0, nts = 0; const unsigned long long rt_entry = STAMP ? (unsigned long long)wall_clock64() : 0ull;
#define PG8_STAMP() do { if (STAMP && wid == 0 && nts < 64) { const unsigned long long _c = (unsigned long long)clock64(); \
        ts_lo = (lane == nts) ? (int)(unsigned)_c : ts_lo; ts_hi = (lane == nts) ? (int)(unsigned)(_c >> 32) : ts_hi; ++nts; } } while (0)
    PG8_STAMP();
    unsigned voffA[2], voffB[2];
#pragma unroll
    for (int i = 0; i < 2; ++i) { int R, C; stage_rc(tid * 16 + i * 8192, R, C); const int Rb = Epi::PERM ? ((R & ~31) + perm32(R & 31)) : R;
        voffA[i] = (unsigned)(R * K + C) * 2u; voffB[i] = (unsigned)(Rb * K + C) * 2u; }
    const size_t kstep = (size_t)(BK * 2);
    const size_t hstep = (size_t)HALF * K * 2;
    const size_t tstep = 2 * hstep;
    const unsigned ldsw = (unsigned)wid * 1024u;
    const int aoff = lds_byte(wr * 64 + fr, fq * 8), boff = lds_byte(wc * 32 + fr, fq * 8);
#define PG8_SA(b, h) (((b) * 2 + (h)) * HTB)
#define PG8_SB(b, h) ((4 + (b) * 2 + (h)) * HTB)
#define PG8_STAGE(bufoff, gbase, voff) do { _Pragma("unroll") for (int _i = 0; _i < 2; ++_i) \
        __builtin_amdgcn_global_load_lds((const unsigned*)((const char*)(gbase) + (voff)[_i]), (PG8_LAS unsigned*)(lds + (bufoff) + ldsw + _i * 8192), 16, 0, 0); } while (0)
#define PG8_LDA(dst, b, h) do { _Pragma("unroll") for (int m = 0; m < 4; ++m) _Pragma("unroll") for (int k = 0; k < 2; ++k) dst[m][k] = *(const PG8_LAS bf16x8*)(lds + PG8_SA(b, h) + aoff + m * 2048 + k * 1024); } while (0)
#define PG8_LDB(dst, b, h) do { _Pragma("unroll") for (int n = 0; n < 2; ++n) _Pragma("unroll") for (int k = 0; k < 2; ++k) dst[n][k] = *(const PG8_LAS bf16x8*)(lds + PG8_SB(b, h) + boff + n * 2048 + k * 1024); } while (0)
#define PG8_MMA(ai, bj, At, Bt) do { __builtin_amdgcn_s_setprio(1); _Pragma("unroll") for (int m = 0; m < 4; ++m) _Pragma("unroll") for (int n = 0; n < 2; ++n) _Pragma("unroll") for (int k = 0; k < 2; ++k) \
        acc[ai][bj][m][n] = __builtin_amdgcn_mfma_f32_16x16x32_bf16(Bt[n][k], At[m][k], acc[ai][bj][m][n], 0, 0, 0); __builtin_amdgcn_s_setprio(0); } while (0)
#define PG8_WAIT_V(n) asm volatile("s_waitcnt vmcnt(" #n ")" ::: "memory")
#define PG8_WAIT_L(n) asm volatile("s_waitcnt lgkmcnt(" #n ")" ::: "memory")
#define PG8_BAR __builtin_amdgcn_s_barrier()
#define PG8_SCHED __builtin_amdgcn_sched_barrier(0)
    Unit cur, nxt; int ui = 0;
    if (!S.next(0, cur)) return;
    f32x4 acc[2][2][4][2];
#pragma unroll
    for (int a = 0; a < 2; ++a)
#pragma unroll
        for (int b = 0; b < 2; ++b)
#pragma unroll
            for (int m = 0; m < 4; ++m)
#pragma unroll
                for (int n = 0; n < 2; ++n) acc[a][b][m][n] = (f32x4){0.f, 0.f, 0.f, 0.f};
    bf16x8 At[4][2], B0[2][2], B1[2][2];
    const char* cA = (const char*)g.A + (size_t)cur.pm * tstep; const char* cB = (const char*)g.Bt + (size_t)cur.pn * tstep;
    S.a_ready(cur);
    PG8_STAGE(PG8_SB(0, 0), cB, voffB); PG8_STAGE(PG8_SA(0, 0), cA, voffA); PG8_STAGE(PG8_SB(0, 1), cB + hstep, voffB); PG8_STAGE(PG8_SA(0, 1), cA + hstep, voffA);
    if (wr == 1) PG8_BAR;
    PG8_WAIT_V(4); PG8_BAR;
    PG8_STAGE(PG8_SB(1, 0), cB + kstep, voffB); PG8_STAGE(PG8_SA(1, 0), cA + kstep, voffA); PG8_STAGE(PG8_SB(1, 1), cB + hstep + kstep, voffB);
    PG8_WAIT_V(6); PG8_BAR;
    PG8_STAMP();
    for (;;) {
        const bool has_next = S.next(ui + 1, nxt);
        const char* nA = has_next ? (const char*)g.A + (size_t)nxt.pm * tstep : cA; const char* nB = has_next ? (const char*)g.Bt + (size_t)nxt.pn * tstep : cB;
        for (int t = 0; t < nt; t += 2) {
            const bool last = (t == nt - 2);
            const char* a1 = cA + (size_t)(t + 1) * kstep;
            const char* a2 = last ? nA : cA + (size_t)(t + 2) * kstep; const char* b2 = last ? nB : cB + (size_t)(t + 2) * kstep;
            const char* a3 = a2 + kstep; const char* b3 = b2 + kstep;
            if (last && has_next) S.a_ready(nxt);
            PG8_LDB(B0, 0, 0); PG8_SCHED; PG8_LDA(At, 0, 0); PG8_STAGE(PG8_SA(1, 1), a1 + hstep, voffA);
            PG8_WAIT_L(8); PG8_BAR; PG8_WAIT_L(0); PG8_MMA(0, 0, At, B0); PG8_BAR; PG8_SCHED;
            PG8_LDB(B1, 0, 1); PG8_STAGE(PG8_SB(0, 0), b2, voffB);
            PG8_BAR; PG8_WAIT_L(0); PG8_MMA(0, 1, At, B1); PG8_BAR;
            PG8_LDA(At, 0, 1); PG8_STAGE(PG8_SA(0, 0), a2, voffA);
            PG8_BAR; PG8_WAIT_L(0); PG8_MMA(1, 0, At, B0); PG8_BAR; PG8_SCHED;
            PG8_STAGE(PG8_SB(0, 1), b2 + hstep, voffB);
            PG8_WAIT_V(6); PG8_BAR; PG8_MMA(1, 1, At, B1); PG8_BAR;
            PG8_LDB(B0, 1, 0); PG8_SCHED; PG8_LDA(At, 1, 0); PG8_STAGE(PG8_SA(0, 1), a2 + hstep, voffA);
            PG8_WAIT_L(8); PG8_BAR; PG8_WAIT_L(0); PG8_MMA(0, 0, At, B0); PG8_BAR; PG8_SCHED;
            PG8_LDB(B1, 1, 1); PG8_STAGE(PG8_SB(1, 0), b3, voffB);
            PG8_BAR; PG8_WAIT_L(0); PG8_MMA(0, 1, At, B1); PG8_BAR;
            PG8_LDA(At, 1, 1); PG8_STAGE(PG8_SA(1, 0), a3, voffA);
            PG8_BAR; PG8_WAIT_L(0); PG8_MMA(1, 0, At, B0); PG8_BAR; PG8_SCHED;
            PG8_STAGE(PG8_SB(1, 1), b3 + hstep, voffB);
            PG8_WAIT_V(6); PG8_BAR; PG8_MMA(1, 1, At, B1); PG8_BAR;
        }
        PG8_STAMP();
        if constexpr (!Epi::AFTER_DRAIN) { E(acc, cur, wr, wc, fr, fq); S.done(cur); }
        PG8_STAMP();
        if (!has_next) break;
#pragma unroll
        for (int a = 0; a < 2; ++a)
#pragma unroll
            for (int b = 0; b < 2; ++b)
#pragma unroll
                for (int m = 0; m < 4; ++m)
#pragma unroll
                    for (int n = 0; n < 2; ++n) acc[a][b][m][n] = (f32x4){0.f, 0.f, 0.f, 0.f};
        cur = nxt; cA = nA; cB = nB; ++ui;
    }
    PG8_WAIT_V(0);
    if (wr == 0) PG8_BAR;
    PG8_BAR;
    if constexpr (Epi::AFTER_DRAIN) { E.fused(acc, cur, wr, wc, fr, fq, lds, wid, lane); S.done(cur); }
    PG8_STAMP();
    if (STAMP && wid == 0) { stamps[lane] = lane < nts ? (((unsigned long long)(unsigned)ts_hi << 32) | (unsigned)ts_lo) : 0ull;
        if (lane == 62) stamps[62] = rt_entry; if (lane == 63) stamps[63] = (unsigned long long)wall_clock64(); }
#undef PG8_STAMP
#undef PG8_SA
#undef PG8_SB
#undef PG8_STAGE
#undef PG8_LDA
#undef PG8_LDB
#undef PG8_MMA
#undef PG8_WAIT_V
#undef PG8_WAIT_L
#undef PG8_BAR
#undef PG8_SCHED
}
}

using pg8::bf16_t; using pg8::f32x4; using pg8::u32x4;
typedef unsigned u32x2 __attribute__((ext_vector_type(2)));
constexpr int D = 2048, DFF = 5632, NB = 4, SEQ = 2048, DEPTH = 2, SBAT = 128, ST = 4;
constexpr int MP = NB * SEQ, MS = SBAT * ST, M = MP + MS;
constexpr int NH = 6, HD = 128, QK = 768, GCONV = 2304, LW = 512, DIN = 7192, DINP = 7424, NGU = 2 * DFF;
constexpr int UZ = 2304, UMQ = 3072, UMK = 3840, UMV = 4608, UMO = 5376, ULX = 6144, ULY = 6656, UGB = 7168, UGA = 7174, UMI = 7180, UMF = 7186;
constexpr float ALPHA = 1.41421356237f, EPS = 1e-6f;
constexpr int NPH_LAYER = 13, NPH = NPH_LAYER * DEPTH;
constexpr size_t O_YP = 0, O_YS = O_YP + (size_t)MP * D;
constexpr size_t SZ_PGS = (size_t)DEPTH * NB * NH * HD * HD, SZ_PGC = (size_t)DEPTH * NB * 3 * GCONV, SZ_PMN = (size_t)DEPTH * NB * NH * HD, SZ_PMM = (size_t)DEPTH * NB * NH, SZ_PLH = (size_t)DEPTH * NB * LW, SZ_PLC = (size_t)DEPTH * NB * 3 * LW;
constexpr size_t O_PGS = O_YS + (size_t)MS * D, O_PGC = O_PGS + SZ_PGS, O_PMC = O_PGC + SZ_PGC, O_PMN = O_PMC + SZ_PGS, O_PMM = O_PMN + SZ_PMN, O_PLH = O_PMM + SZ_PMM, O_PLC = O_PLH + SZ_PLH;
constexpr size_t SZ_SGS = (size_t)DEPTH * SBAT * NH * HD * HD, SZ_SGC = (size_t)DEPTH * SBAT * 3 * GCONV, SZ_SMN = (size_t)DEPTH * SBAT * NH * HD, SZ_SMM = (size_t)DEPTH * SBAT * NH, SZ_SLH = (size_t)DEPTH * SBAT * LW, SZ_SLC = (size_t)DEPTH * SBAT * 3 * LW;
constexpr size_t O_SGS = O_PLC + SZ_PLC, O_SGC = O_SGS + SZ_SGS, O_SMC = O_SGC + SZ_SGC, O_SMN = O_SMC + SZ_SGS, O_SMM = O_SMN + SZ_SMN, O_SLH = O_SMM + SZ_SMM, O_SLC = O_SLH + SZ_SLH, O_END = O_SLC + SZ_SLC;
constexpr size_t al256(size_t x) { return (x + 255) & ~(size_t)255; }
constexpr size_t WS_CTL = 0, WS_WGU1 = 4096, WS_WD1 = WS_WGU1 + (size_t)NGU * D * 2, WS_WIN = WS_WD1 + (size_t)D * DFF * 2, WS_WOUT = WS_WIN + (size_t)DINP * D * 2,
    WS_WGU2 = WS_WOUT + (size_t)D * D * 2, WS_WD2 = WS_WGU2 + (size_t)NGU * D * 2, WS_XF = WS_WD2 + (size_t)D * DFF * 2, WS_XB = WS_XF + (size_t)M * D * 4,
    WS_Z = WS_XB + (size_t)M * D * 2, WS_BIG = WS_Z + (size_t)M * D * 4, WS_GQ = WS_BIG + (size_t)M * DINP * 4, WS_GK = WS_GQ + (size_t)M * QK * 4, WS_GV = WS_GK + (size_t)M * QK * 4,
    WS_LA = WS_GV + (size_t)M * QK * 4, WS_LU = WS_LA + (size_t)M * LW * 4, WS_SC = WS_LU + (size_t)M * LW * 4, WS_MIX = WS_SC + (size_t)4 * M * 8 * 4, WS_END = WS_MIX + (size_t)M * D * 2;

struct Params { const float* in[33]; float* out; unsigned char* ws; int ph_lo, ph_hi; };

__device__ __forceinline__ unsigned char* ows(const Params& p) { unsigned char* w = p.ws; asm volatile("" : "+s"(w)); return w; }
__device__ __forceinline__ float sigmoidf_(float x) { return 1.0f / (1.0f + expf(-x)); }
__device__ __forceinline__ float siluf_(float x) { return x / (1.0f + expf(-x)); }
__device__ __forceinline__ float softplusf_(float x) { return fmaxf(x, 0.f) + log1pf(expf(-fabsf(x))); }
__device__ __forceinline__ float silu_fast(float x) { return x * __builtin_amdgcn_rcpf(1.0f + __expf(-x)); }
template <int CTRL> __device__ __forceinline__ float dppf(float x) { return __builtin_bit_cast(float, __builtin_amdgcn_mov_dpp(__builtin_bit_cast(int, x), CTRL, 0xf, 0xf, true)); }
__device__ __forceinline__ float allreduce16(float x) { x += dppf<0xB1>(x); x += dppf<0x4E>(x); x += dppf<0x141>(x); x += dppf<0x128>(x); return x; }
__device__ __forceinline__ float reduce32(float x) { x += __shfl_xor(x, 1); x += __shfl_xor(x, 2); x += __shfl_xor(x, 4); x += __shfl_xor(x, 8); x += __shfl_xor(x, 16); return x; }
__device__ __forceinline__ float reduce64(float x) { x = reduce32(x); x += __shfl_xor(x, 32); return x; }

__device__ __forceinline__ int otid() { int t = threadIdx.x; asm volatile("" : "+v"(t)); return t; }
__device__ __forceinline__ int obid() { int t = blockIdx.x; asm volatile("" : "+s"(t)); return t; }
struct EpiSwiglu {
    static constexpr bool PERM = true, AFTER_DRAIN = false;
    bf16_t* H; int ldh;
    __device__ __forceinline__ void operator()(const f32x4 (&acc)[2][2][4][2], const pg8::Unit& u, int wr, int wc, int fr, int fq) const {
        const int row0 = u.pm * 256 + wr * 64 + fr, col0 = u.pn * 128 + wc * 32 + 8 * fq;
#pragma unroll
        for (int ai = 0; ai < 2; ++ai)
#pragma unroll
            for (int m = 0; m < 4; ++m) {
                bf16_t* rowp = H + (size_t)(row0 + ai * 128 + m * 16) * ldh + col0;
                const f32x4 g0 = acc[ai][0][m][0], g1 = acc[ai][0][m][1], u0 = acc[ai][1][m][0], u1 = acc[ai][1][m][1];
                u32x4 w;
                w.x = pg8::cvt_pk_bf16(silu_fast(g0[0]) * u0[0], silu_fast(g0[1]) * u0[1]); w.y = pg8::cvt_pk_bf16(silu_fast(g0[2]) * u0[2], silu_fast(g0[3]) * u0[3]);
                w.z = pg8::cvt_pk_bf16(silu_fast(g1[0]) * u1[0], silu_fast(g1[1]) * u1[1]); w.w = pg8::cvt_pk_bf16(silu_fast(g1[2]) * u1[2], silu_fast(g1[3]) * u1[3]);
                *(u32x4*)rowp = w;
            }
    }
};
struct EpiRes {
    static constexpr bool PERM = false, AFTER_DRAIN = false;
    const float* X; float* Z; int ld; float s;
    __device__ __forceinline__ void operator()(const f32x4 (&acc)[2][2][4][2], const pg8::Unit& u, int wr, int wc, int fr, int fq) const {
        const int row0 = u.pm * 256 + wr * 64 + fr, col0 = u.pn * 256 + wc * 32 + 4 * fq;
#pragma unroll
        for (int ai = 0; ai < 2; ++ai)
#pragma unroll
            for (int m = 0; m < 4; ++m) {
                const size_t off = (size_t)(row0 + ai * 128 + m * 16) * ld + col0;
#pragma unroll
                for (int bj = 0; bj < 2; ++bj)
#pragma unroll
                    for (int n = 0; n < 2; ++n) { const f32x4 xv = *(const f32x4*)(X + off + bj * 128 + n * 16); *(f32x4*)(Z + off + bj * 128 + n * 16) = xv * ALPHA + acc[ai][bj][m][n] * s; }
                asm volatile("" ::: "memory");
            }
    }
};

template <int MODE> __device__ __forceinline__ int map_row(int n) {
    if (MODE == 0) return n;
    if (MODE == 1) return 256 * (n >> 7) + (n & 127);
    if (MODE == 2) return 256 * (n >> 7) + 128 + (n & 127);
    if (n < 3072) return n;
    if (n < 3078) return UGB + (n - 3072);
    if (n < 3084) return UGA + (n - 3078);
    if (n < 6156) return n - 12;
    if (n < 6162) return UMI + (n - 6156);
    if (n < 6168) return UMF + (n - 6162);
    return n - 24;
}
template <int MODE> __device__ __forceinline__ void convert_w(const float* __restrict__ W, int K, int N, bf16_t* __restrict__ Bt, float* tile) {
    const int tid = otid(), ntn = (N + 63) >> 6, ntiles = ntn * (K >> 6);
    for (int t = obid(); t < ntiles; t += gridDim.x) {
        const int tk = t / ntn, tn = t - tk * ntn, k0 = tk * 64, n0 = tn * 64;
        { const int nn = tid & 63, kk = tid >> 6, n = n0 + nn;
#pragma unroll
          for (int i = 0; i < 8; ++i) { const int k = kk + 8 * i; tile[nn * 65 + k] = (n < N) ? W[(size_t)(k0 + k) * N + n] : 0.f; } }
        __syncthreads();
        { const int nn = tid >> 3, ks = (tid & 7) * 8, n = n0 + nn;
          if (n < N) { const float* tp = tile + nn * 65 + ks; u32x4 w; w.x = pg8::cvt_pk_bf16(tp[0], tp[1]); w.y = pg8::cvt_pk_bf16(tp[2], tp[3]); w.z = pg8::cvt_pk_bf16(tp[4], tp[5]); w.w = pg8::cvt_pk_bf16(tp[6], tp[7]);
              *(u32x4*)(Bt + (size_t)map_row<MODE>(n) * K + k0 + ks) = w; } }
        __syncthreads();
    }
}
__device__ __forceinline__ void phase_convert(const Params& p, int d, float* lds) {
    unsigned char* ws = ows(p);
    convert_w<1>(p.in[9] + (size_t)d * D * DFF, D, DFF, (bf16_t*)(ws + WS_WGU1), lds);
    convert_w<2>(p.in[10] + (size_t)d * D * DFF, D, DFF, (bf16_t*)(ws + WS_WGU1), lds);
    convert_w<0>(p.in[11] + (size_t)d * DFF * D, DFF, D, (bf16_t*)(ws + WS_WD1), lds);
    convert_w<3>(p.in[14] + (size_t)d * D * DIN, D, DIN, (bf16_t*)(ws + WS_WIN), lds);
    convert_w<0>(p.in[29] + (size_t)d * D * D, D, D, (bf16_t*)(ws + WS_WOUT), lds);
    convert_w<1>(p.in[30] + (size_t)d * D * DFF, D, DFF, (bf16_t*)(ws + WS_WGU2), lds);
    convert_w<2>(p.in[31] + (size_t)d * D * DFF, D, DFF, (bf16_t*)(ws + WS_WGU2), lds);
    convert_w<0>(p.in[32] + (size_t)d * DFF * D, DFF, D, (bf16_t*)(ws + WS_WD2), lds);
    const size_t gt = (size_t)obid() * 512 + otid(), gn = (size_t)gridDim.x * 512;
    if (d == 0) {
        u32x4* zp = (u32x4*)((bf16_t*)(ws + WS_WIN) + (size_t)DIN * D);
        for (size_t i = gt; i < (size_t)(DINP - DIN) * D / 8; i += gn) zp[i] = (u32x4){0u, 0u, 0u, 0u};
        float* XF = (float*)(ws + WS_XF); bf16_t* XB = (bf16_t*)(ws + WS_XB);
        for (size_t i = gt; i < (size_t)M * D / 4; i += gn) {
            const f32x4 v = (i < (size_t)MP * D / 4) ? ((const f32x4*)p.in[0])[i] : ((const f32x4*)p.in[1])[i - (size_t)MP * D / 4];
            ((f32x4*)XF)[i] = v; u32x2 w; w.x = pg8::cvt_pk_bf16(v[0], v[1]); w.y = pg8::cvt_pk_bf16(v[2], v[3]); ((u32x2*)XB)[i] = w;
        }
    }
}

__device__ __forceinline__ void phase_ln(const float* __restrict__ Z, const float* __restrict__ g, const float* __restrict__ b, float* __restrict__ XF, bf16_t* __restrict__ XB) {
    const int tid = otid(), lane = tid & 63, gw = obid() * 8 + (tid >> 6), nw = gridDim.x * 8;
    for (int row = gw; row < M; row += nw) {
        const f32x4* zp = (const f32x4*)(Z + (size_t)row * D);
        f32x4 v[8]; float s = 0.f;
#pragma unroll
        for (int i = 0; i < 8; ++i) { v[i] = zp[lane + 64 * i]; s += (v[i][0] + v[i][1]) + (v[i][2] + v[i][3]); }
        s = reduce64(s); const float mu = s * (1.0f / D); float q = 0.f;
#pragma unroll
        for (int i = 0; i < 8; ++i) { const f32x4 dd = v[i] - mu; q += (dd[0] * dd[0] + dd[1] * dd[1]) + (dd[2] * dd[2] + dd[3] * dd[3]); }
        q = reduce64(q); const float rs = rsqrtf(q * (1.0f / D) + EPS);
#pragma unroll
        for (int i = 0; i < 8; ++i) {
            const int c4 = lane + 64 * i; const f32x4 gv = ((const f32x4*)g)[c4], bv = ((const f32x4*)b)[c4];
            const f32x4 o = (v[i] - mu) * rs * gv + bv;
            ((f32x4*)(XF + (size_t)row * D))[c4] = o;
            u32x2 w; w.x = pg8::cvt_pk_bf16(o[0], o[1]); w.y = pg8::cvt_pk_bf16(o[2], o[3]); ((u32x2*)(XB + (size_t)row * D))[c4] = w;
        }
    }
}

struct RowInfo { int prompt, t, b, T; };
__device__ __forceinline__ RowInfo row_info(int r) { RowInfo ri; ri.prompt = r < MP; if (ri.prompt) { ri.t = r & (SEQ - 1); ri.b = r >> 11; ri.T = SEQ; } else { ri.t = (r - MP) & 3; ri.b = (r - MP) >> 2; ri.T = ST; } return ri; }
constexpr int TG = 17, NGRP = M / TG;
__device__ __forceinline__ void phase_prep(const Params& p, int d, float* lds) {
    unsigned char* ws = ows(p); const int tid = otid();
    const float* U = (const float*)(ws + WS_BIG);
    float* GQ = (float*)(ws + WS_GQ); float* GK = (float*)(ws + WS_GK); float* GV = (float*)(ws + WS_GV);
    float* LA = (float*)(ws + WS_LA); float* LU = (float*)(ws + WS_LU);
    float* SCB = (float*)(ws + WS_SC); float* SCE = SCB + (size_t)M * 8; float* SCI = SCE + (size_t)M * 8; float* SCF = SCI + (size_t)M * 8;
    const float* gcw = p.in[15] + (size_t)d * 4 * GCONV; const float* A_log = p.in[16] + d * NH; const float* dtb = p.in[17] + d * NH;
    const float* ibias = p.in[19] + d * NH; const float* fbias = p.in[20] + d * NH;
    const float* lcw = p.in[22] + (size_t)d * 4 * LW; const float* lcb = p.in[23] + (size_t)d * LW;
    const float* wr = p.in[24] + (size_t)d * 8 * 64 * 64; const float* br = p.in[25] + (size_t)d * LW; const float* wi = p.in[26] + (size_t)d * 8 * 64 * 64; const float* bi = p.in[27] + (size_t)d * LW;
    const float* lam = p.in[28] + (size_t)d * LW;
    const float* sgc = p.in[3] + (size_t)d * SBAT * 3 * GCONV; const float* slc = p.in[8] + (size_t)d * SBAT * 3 * LW;
    float* o_pgc = p.out + O_PGC + (size_t)d * NB * 3 * GCONV; float* o_sgc = p.out + O_SGC + (size_t)d * SBAT * 3 * GCONV;
    float* o_plc = p.out + O_PLC + (size_t)d * NB * 3 * LW; float* o_slc = p.out + O_SLC + (size_t)d * SBAT * 3 * LW;
    float* cx = lds;
    for (int grp = obid(); grp < NGRP; grp += gridDim.x) {
        const int r0 = grp * TG;
        for (int idx = tid; idx < TG * 576; idx += 512) {
            const int tok = idx / 576, c = (idx - tok * 576) * 4, r = r0 + tok; const RowInfo ri = row_info(r);
            const f32x4 z4 = (f32x4){0.f, 0.f, 0.f, 0.f};
            const f32x4 x3 = *(const f32x4*)(U + (size_t)r * DINP + c);
            f32x4 xl[3];
#pragma unroll
            for (int L = 1; L <= 3; ++L) {
                f32x4 v;
                if (ri.t - L >= 0) v = *(const f32x4*)(U + (size_t)(r - L) * DINP + c);
                else if (ri.prompt) v = z4;
                else v = *(const f32x4*)(sgc + ((size_t)ri.b * 3 + (3 + ri.t - L)) * GCONV + c);
                xl[L - 1] = v;
            }
            const f32x4 w0 = *(const f32x4*)(gcw + c), w1 = *(const f32x4*)(gcw + GCONV + c), w2 = *(const f32x4*)(gcw + 2 * GCONV + c), w3 = *(const f32x4*)(gcw + 3 * GCONV + c);
            f32x4 y = w0 * xl[2] + w1 * xl[1] + w2 * xl[0] + w3 * x3;
#pragma unroll
            for (int j = 0; j < 4; ++j) y[j] = siluf_(y[j]);
            float ss = (y[0] * y[0] + y[1] * y[1]) + (y[2] * y[2] + y[3] * y[3]);
            ss = reduce32(ss);
            if (c < QK) { *(f32x4*)(GQ + (size_t)r * QK + c) = y * (rsqrtf(ss + EPS) * 0.08838834764831845f); }
            else if (c < 2 * QK) { *(f32x4*)(GK + (size_t)r * QK + (c - QK)) = y * rsqrtf(ss + EPS); }
            else { *(f32x4*)(GV + (size_t)r * QK + (c - 2 * QK)) = y; }
            if (ri.t >= ri.T - 3) { const int j = ri.t - (ri.T - 3); float* dst = ri.prompt ? o_pgc : o_sgc; *(f32x4*)(dst + ((size_t)ri.b * 3 + j) * GCONV + c) = x3; }
        }
        if (tid < TG * NH) {
            const int tok = tid / NH, h = tid - tok * NH, r = r0 + tok; const float* ur = U + (size_t)r * DINP;
            const float beta = sigmoidf_(ur[UGB + h]);
            const float g = -expf(A_log[h]) * softplusf_(ur[UGA + h] + dtb[h]);
            SCB[(size_t)r * 8 + h] = beta; SCE[(size_t)r * 8 + h] = expf(g);
            SCI[(size_t)r * 8 + h] = ur[UMI + h] + ibias[h];
            SCF[(size_t)r * 8 + h] = -softplusf_(-(ur[UMF + h] + fbias[h]));
        }
        for (int idx = tid; idx < TG * 128; idx += 512) {
            const int tok = idx >> 7, c = (idx & 127) * 4, r = r0 + tok; const RowInfo ri = row_info(r);
            const f32x4 z4 = (f32x4){0.f, 0.f, 0.f, 0.f};
            const f32x4 x3 = *(const f32x4*)(U + (size_t)r * DINP + ULX + c);
            f32x4 xl[3];
#pragma unroll
            for (int L = 1; L <= 3; ++L) {
                f32x4 v;
                if (ri.t - L >= 0) v = *(const f32x4*)(U + (size_t)(r - L) * DINP + ULX + c);
                else if (ri.prompt) v = z4;
                else v = *(const f32x4*)(slc + ((size_t)ri.b * 3 + (3 + ri.t - L)) * LW + c);
                xl[L - 1] = v;
            }
            const f32x4 w0 = *(const f32x4*)(lcw + c), w1 = *(const f32x4*)(lcw + LW + c), w2 = *(const f32x4*)(lcw + 2 * LW + c), w3 = *(const f32x4*)(lcw + 3 * LW + c);
            const f32x4 y = w0 * xl[2] + w1 * xl[1] + w2 * xl[0] + w3 * x3 + *(const f32x4*)(lcb + c);
            *(f32x4*)(cx + tok * LW + c) = y;
            if (ri.t >= ri.T - 3) { const int j = ri.t - (ri.T - 3); float* dst = ri.prompt ? o_plc : o_slc; *(f32x4*)(dst + ((size_t)ri.b * 3 + j) * LW + c) = x3; }
        }
        __syncthreads();
        {
            const int c = tid, blk = c >> 6, e = c & 63;
            float ar[TG], ai[TG];
#pragma unroll
            for (int k = 0; k < TG; ++k) { ar[k] = 0.f; ai[k] = 0.f; }
            const float* wrp = wr + (size_t)blk * 4096 + e; const float* wip = wi + (size_t)blk * 4096 + e; const float* cxb = cx + blk * 64;
#pragma unroll 4
            for (int dd = 0; dd < 64; ++dd) {
                const float wrv = wrp[dd * 64], wiv = wip[dd * 64];
#pragma unroll
                for (int k = 0; k < TG; ++k) { const float x = cxb[k * LW + dd]; ar[k] = fmaf(x, wrv, ar[k]); ai[k] = fmaf(x, wiv, ai[k]); }
            }
            const float brv = br[c], biv = bi[c], spl = softplusf_(-lam[c]);
#pragma unroll
            for (int k = 0; k < TG; ++k) {
                const int r = r0 + k;
                const float rg = sigmoidf_(ar[k] + brv), ig = sigmoidf_(ai[k] + biv);
                const float log_a = -8.0f * rg * spl;
                LA[(size_t)r * LW + c] = expf(log_a);
                LU[(size_t)r * LW + c] = sqrtf(-expm1f(2.0f * log_a)) * (ig * cx[k * LW + c]);
            }
        }
        __syncthreads();
    }
}

template <int NC> struct GTok { f32x4 k0, k1, q0, q1; float v[NC]; float a, b; };
template <int NC> __device__ __forceinline__ void tok_load(GTok<NC>& t, const float* kp, const float* qp, const float* vp, const float* ap, const float* bp) {
    t.k0 = *(const f32x4*)kp; t.k1 = *(const f32x4*)(kp + 4); t.q0 = *(const f32x4*)qp; t.q1 = *(const f32x4*)(qp + 4);
    if (NC == 4) { const f32x4 vv = *(const f32x4*)vp; t.v[0] = vv[0]; t.v[NC > 1 ? 1 : 0] = vv[1]; t.v[NC > 2 ? 2 : 0] = vv[2]; t.v[NC > 3 ? 3 : 0] = vv[3]; }
    else {
#pragma unroll
        for (int j = 0; j < NC; ++j) t.v[j] = vp[j];
    }
    t.a = *ap; t.b = *bp;
}
template <int NC> __device__ __forceinline__ void store_nc(float* dst, const float (&o)[NC]) {
    if (NC == 4) *(f32x4*)dst = (f32x4){o[0], o[NC > 1 ? 1 : 0], o[NC > 2 ? 2 : 0], o[NC > 3 ? 3 : 0]};
    else {
#pragma unroll
        for (int j = 0; j < NC; ++j) dst[j] = o[j];
    }
}
template <int NC> __device__ __forceinline__ void gdn_step(float (&S)[8][NC], const GTok<NC>& t, float* orow, bool writer) {
    const float kk[8] = {t.k0[0], t.k0[1], t.k0[2], t.k0[3], t.k1[0], t.k1[1], t.k1[2], t.k1[3]};
    const float qq[8] = {t.q0[0], t.q0[1], t.q0[2], t.q0[3], t.q1[0], t.q1[1], t.q1[2], t.q1[3]};
    float u[NC], o[NC];
#pragma unroll
    for (int j = 0; j < NC; ++j) { float r = 0.f;
#pragma unroll
        for (int i = 0; i < 8; ++i) r = fmaf(S[i][j], kk[i], r);
        r = allreduce16(r); u[j] = t.a * (t.v[j] - t.b * r); }
#pragma unroll
    for (int j = 0; j < NC; ++j) { float a = 0.f;
#pragma unroll
        for (int i = 0; i < 8; ++i) { S[i][j] = fmaf(kk[i], u[j], t.b * S[i][j]); a = fmaf(S[i][j], qq[i], a); }
        o[j] = allreduce16(a); }
    if (writer) store_nc<NC>(orow, o);
}
template <int NC> __device__ __forceinline__ void mls_step(float (&C)[8][NC], float (&n)[8], float& m, const GTok<NC>& t, float* orow, bool writer) {
    const float kk[8] = {t.k0[0], t.k0[1], t.k0[2], t.k0[3], t.k1[0], t.k1[1], t.k1[2], t.k1[3]};
    const float qq[8] = {t.q0[0], t.q0[1], t.q0[2], t.q0[3], t.q1[0], t.q1[1], t.q1[2], t.q1[3]};
    const float mn = fmaxf(t.b + m, t.a), fd = expf(t.b + m - mn), iw = expf(t.a - mn) * 0.08838834764831845f; m = mn;
    float den = 0.f, kw[8];
#pragma unroll
    for (int i = 0; i < 8; ++i) { kw[i] = iw * kk[i]; n[i] = fmaf(fd, n[i], kw[i]); den = fmaf(n[i], qq[i], den); }
    den = allreduce16(den);
    const float inv = 1.0f / fmaxf(fabsf(den), expf(-mn));
    float o[NC];
#pragma unroll
    for (int j = 0; j < NC; ++j) { float a = 0.f;
#pragma unroll
        for (int i = 0; i < 8; ++i) { C[i][j] = fmaf(kw[i], t.v[j], fd * C[i][j]); a = fmaf(C[i][j], qq[i], a); }
        o[j] = allreduce16(a) * inv; }
    if (writer) store_nc<NC>(orow, o);
}

template <int NC, int KIND> __device__ __forceinline__ void mixer_item(const Params& p, int d, int prompt, int b, int h, int slab, int lane) {
    unsigned char* ws = ows(p);
    const int ks = lane & 15, cl = lane >> 4, cb = slab * (4 * NC) + cl * NC;
    const int T = prompt ? SEQ : ST, rbase = prompt ? b * SEQ : MP + b * ST;
    const float *kp, *qp, *vp, *ap, *bp; size_t kstride;
    if (KIND == 0) { kp = (const float*)(ws + WS_GK) + (size_t)rbase * QK + h * HD + 8 * ks; qp = (const float*)(ws + WS_GQ) + (size_t)rbase * QK + h * HD + 8 * ks; vp = (const float*)(ws + WS_GV) + (size_t)rbase * QK + h * HD + cb; kstride = QK;
        ap = (const float*)(ws + WS_SC) + (size_t)rbase * 8 + h; bp = ap + (size_t)M * 8; }
    else { const float* U = (const float*)(ws + WS_BIG) + (size_t)rbase * DINP; kp = U + UMK + h * HD + 8 * ks; qp = U + UMQ + h * HD + 8 * ks; vp = U + UMV + h * HD + cb; kstride = DINP;
        ap = (const float*)(ws + WS_SC) + (size_t)2 * M * 8 + (size_t)rbase * 8 + h; bp = ap + (size_t)M * 8; }
    float* orow = (float*)(ws + WS_Z) + (size_t)rbase * D + (KIND == 0 ? 0 : QK) + h * HD + cb;
    const int nbatch = prompt ? NB : SBAT;
    const size_t sidx = ((size_t)(d * nbatch + b) * NH + h);
    float S[8][NC], n[8], m = 0.f;
#pragma unroll
    for (int i = 0; i < 8; ++i) { n[i] = 0.f;
#pragma unroll
        for (int j = 0; j < NC; ++j) S[i][j] = 0.f; }
    if (!prompt) {
        const float* S0 = p.in[KIND == 0 ? 2 : 4] + sidx * HD * HD + (size_t)(8 * ks) * HD + cb;
#pragma unroll
        for (int i = 0; i < 8; ++i) {
            if (NC == 4) { const f32x4 v = *(const f32x4*)(S0 + i * HD); S[i][0] = v[0]; S[i][NC > 1 ? 1 : 0] = v[1]; S[i][NC > 2 ? 2 : 0] = v[2]; S[i][NC > 3 ? 3 : 0] = v[3]; }
            else {
#pragma unroll
                for (int j = 0; j < NC; ++j) S[i][j] = S0[i * HD + j];
            }
        }
        if (KIND == 1) {
            const float* n0 = p.in[5] + sidx * HD + 8 * ks;
#pragma unroll
            for (int i = 0; i < 8; ++i) n[i] = n0[i];
            m = p.in[6][sidx];
        }
    }
    const bool writer = (ks == 0);
    GTok<NC> A[4], B[4];
    const int nblk = T >> 2;
#define LOADBLK(buf, blk) do { _Pragma("unroll") for (int q_ = 0; q_ < 4; ++q_) { const size_t t_ = (size_t)(blk) * 4 + q_; tok_load<NC>(buf[q_], kp + t_ * kstride, qp + t_ * kstride, vp + t_ * kstride, ap + t_ * 8, bp + t_ * 8); } } while (0)
#define COMPBLK(buf, blk) do { _Pragma("unroll") for (int q_ = 0; q_ < 4; ++q_) { const size_t t_ = (size_t)(blk) * 4 + q_; \
        if (KIND == 0) gdn_step<NC>(S, buf[q_], orow + t_ * D, writer); else mls_step<NC>(S, n, m, buf[q_], orow + t_ * D, writer); } } while (0)
    LOADBLK(A, 0);
    for (int blk = 0; blk < nblk; blk += 2) {
        if (blk + 1 < nblk) LOADBLK(B, blk + 1);
        COMPBLK(A, blk);
        if (blk + 1 < nblk) {
            if (blk + 2 < nblk) LOADBLK(A, blk + 2);
            COMPBLK(B, blk + 1);
        }
    }
#undef LOADBLK
#undef COMPBLK
    float* So = p.out + (KIND == 0 ? (prompt ? O_PGS : O_SGS) : (prompt ? O_PMC : O_SMC)) + sidx * HD * HD + (size_t)(8 * ks) * HD + cb;
#pragma unroll
    for (int i = 0; i < 8; ++i) { float tmp[NC];
#pragma unroll
        for (int j = 0; j < NC; ++j) tmp[j] = S[i][j];
        store_nc<NC>(So + i * HD, tmp); }
    if (KIND == 1 && slab == 0) {
        if (cl == 0) { float* no = p.out + (prompt ? O_PMN : O_SMN) + sidx * HD + 8 * ks;
#pragma unroll
            for (int i = 0; i < 8; ++i) no[i] = n[i]; }
        if (lane == 0) p.out[(prompt ? O_PMM : O_SMM) + sidx] = m;
    }
}
__device__ __forceinline__ void lru_item(const Params& p, int d, int prompt, int b, int grp, int lane) {
    unsigned char* ws = ows(p);
    const int c = grp * 64 + lane, T = prompt ? SEQ : ST, rbase = prompt ? b * SEQ : MP + b * ST;
    const float* la = (const float*)(ws + WS_LA) + (size_t)rbase * LW + c; const float* lu = (const float*)(ws + WS_LU) + (size_t)rbase * LW + c;
    float* orow = (float*)(ws + WS_Z) + (size_t)rbase * D + 2 * QK + c;
    float hst = prompt ? 0.f : p.in[7][((size_t)d * SBAT + b) * LW + c];
    for (int t = 0; t < T; t += 4) {
        float a[4], u[4];
#pragma unroll
        for (int q = 0; q < 4; ++q) { a[q] = la[(size_t)(t + q) * LW]; u[q] = lu[(size_t)(t + q) * LW]; }
#pragma unroll
        for (int q = 0; q < 4; ++q) { hst = fmaf(a[q], hst, u[q]); orow[(size_t)(t + q) * D] = hst; }
    }
    p.out[(prompt ? O_PLH : O_SLH) + ((size_t)d * (prompt ? NB : SBAT) + b) * LW + c] = hst;
}
constexpr int IT_GP = 0, IT_MP = IT_GP + NB * NH * 32, IT_LP = IT_MP + NB * NH * 32, IT_GS = IT_LP + NB * 8, IT_MS = IT_GS + SBAT * NH * 8, IT_LS = IT_MS + SBAT * NH * 8, IT_END = IT_LS + SBAT * 8;
__device__ __forceinline__ void phase_scan(const Params& p, int d) {
    unsigned* ctr = (unsigned*)(ows(p) + WS_CTL) + 64 * (1 + d);
    const int lane = otid() & 63;
    for (;;) {
        unsigned it = 0;
        if (lane == 0) it = atomicAdd(ctr, 1u);
        it = (unsigned)__builtin_amdgcn_readfirstlane((int)it);
        if (it >= (unsigned)IT_END) break;
        if (it < (unsigned)IT_MP) { const int x = it - IT_GP, bh = x >> 5; mixer_item<1, 0>(p, d, 1, bh / NH, bh % NH, x & 31, lane); }
        else if (it < (unsigned)IT_LP) { const int x = it - IT_MP, bh = x >> 5; mixer_item<1, 1>(p, d, 1, bh / NH, bh % NH, x & 31, lane); }
        else if (it < (unsigned)IT_GS) { const int x = it - IT_LP; lru_item(p, d, 1, x >> 3, x & 7, lane); }
        else if (it < (unsigned)IT_MS) { const int x = it - IT_GS, bh = x >> 3; mixer_item<4, 0>(p, d, 0, bh / NH, bh % NH, x & 7, lane); }
        else if (it < (unsigned)IT_LS) { const int x = it - IT_MS, bh = x >> 3; mixer_item<4, 1>(p, d, 0, bh / NH, bh % NH, x & 7, lane); }
        else { const int x = it - IT_LS; lru_item(p, d, 0, x >> 3, x & 7, lane); }
    }
}

__device__ __forceinline__ float gelu_tanh(float y) { return 0.5f * y * (1.0f + tanhf(0.7978845608028654f * (y + 0.044715f * y * y * y))); }
__device__ __forceinline__ void phase_post(const Params& p, int d) {
    unsigned char* ws = ows(p);
    const float* U = (const float*)(ws + WS_BIG); const float* OR = (const float*)(ws + WS_Z); bf16_t* MIX = (bf16_t*)(ws + WS_MIX);
    const float* gnw = p.in[18] + (size_t)d * HD; const float* mnw = p.in[21] + (size_t)d * QK;
    const int tid = otid(), lane = tid & 63, gw = obid() * 8 + (tid >> 6), nw = gridDim.x * 8;
    for (int row = gw; row < M; row += nw) {
        const float* orow = OR + (size_t)row * D; const float* ur = U + (size_t)row * DINP; bf16_t* mrow = MIX + (size_t)row * D;
#pragma unroll
        for (int i = 0; i < 3; ++i) {
            const int c = (lane + 64 * i) * 4;
            const f32x4 o = *(const f32x4*)(orow + c); float ss = (o[0] * o[0] + o[1] * o[1]) + (o[2] * o[2] + o[3] * o[3]); ss = reduce32(ss);
            const float rs = rsqrtf(ss * (1.0f / HD) + EPS); const f32x4 w = *(const f32x4*)(gnw + (c & 127)), z = *(const f32x4*)(ur + UZ + c);
            float r[4];
#pragma unroll
            for (int j = 0; j < 4; ++j) r[j] = o[j] * rs * w[j] * siluf_(z[j]);
            u32x2 pk; pk.x = pg8::cvt_pk_bf16(r[0], r[1]); pk.y = pg8::cvt_pk_bf16(r[2], r[3]); *(u32x2*)(mrow + c) = pk;
        }
#pragma unroll
        for (int i = 0; i < 3; ++i) {
            const int c = (lane + 64 * i) * 4;
            const f32x4 o = *(const f32x4*)(orow + QK + c); float ss = (o[0] * o[0] + o[1] * o[1]) + (o[2] * o[2] + o[3] * o[3]); ss = reduce32(ss);
            const float rs = rsqrtf(ss * (1.0f / HD) + EPS); const f32x4 w = *(const f32x4*)(mnw + c), z = *(const f32x4*)(ur + UMO + c);
            float r[4];
#pragma unroll
            for (int j = 0; j < 4; ++j) r[j] = o[j] * rs * w[j] * sigmoidf_(z[j]);
            u32x2 pk; pk.x = pg8::cvt_pk_bf16(r[0], r[1]); pk.y = pg8::cvt_pk_bf16(r[2], r[3]); *(u32x2*)(mrow + QK + c) = pk;
        }
#pragma unroll
        for (int i = 0; i < 2; ++i) {
            const int c = (lane + 64 * i) * 4;
            const f32x4 o = *(const f32x4*)(orow + 2 * QK + c), y = *(const f32x4*)(ur + ULY + c);
            float r[4];
#pragma unroll
            for (int j = 0; j < 4; ++j) r[j] = o[j] * gelu_tanh(y[j]);
            u32x2 pk; pk.x = pg8::cvt_pk_bf16(r[0], r[1]); pk.y = pg8::cvt_pk_bf16(r[2], r[3]); *(u32x2*)(mrow + 2 * QK + c) = pk;
        }
    }
}

constexpr int LDS_BYTES = pg8::STAGE_BYTES;
__global__ void __launch_bounds__(512) hybrid_fwd(Params p) {
    extern __shared__ __attribute__((aligned(16))) unsigned char lds[];
    cg::grid_group grid = cg::this_grid();
    for (int ph = p.ph_lo; ph < p.ph_hi; ++ph) {
        unsigned char* ws = ows(p);
        float* XF = (float*)(ws + WS_XF); bf16_t* XB = (bf16_t*)(ws + WS_XB); float* Z = (float*)(ws + WS_Z);
        bf16_t* HB = (bf16_t*)(ws + WS_BIG); float* U = (float*)(ws + WS_BIG); bf16_t* MIX = (bf16_t*)(ws + WS_MIX);
        const int d = ph / NPH_LAYER, s = ph - d * NPH_LAYER;
        const float* lng = p.in[12] + (size_t)d * 3 * D; const float* lnb = p.in[13] + (size_t)d * 3 * D;
        switch (s) {
        case 0: phase_convert(p, d, (float*)lds); break;
        case 1: case 10: {
            pg8::Gemm g{XB, (const bf16_t*)(ws + (s == 1 ? WS_WGU1 : WS_WGU2)), M, NGU, D}; pg8::StaticOrder S; S.init(M, NGU, gridDim.x, obid());
            EpiSwiglu E{HB, DFF}; pg8::gemm_phase<EpiSwiglu, pg8::StaticOrder, false>((PG8_LAS unsigned char*)lds, g, S, E, nullptr); break; }
        case 2: case 8: case 11: {
            const bf16_t* A = (s == 8) ? MIX : HB; const bf16_t* Bt = (const bf16_t*)(ws + (s == 2 ? WS_WD1 : (s == 8 ? WS_WOUT : WS_WD2)));
            pg8::Gemm g{A, Bt, M, D, (s == 8) ? D : DFF}; pg8::StaticOrder S; S.init(M, D, gridDim.x, obid());
            EpiRes E{XF, Z, D, (s == 8) ? 1.0f : 0.5f}; pg8::gemm_phase<EpiRes, pg8::StaticOrder, false>((PG8_LAS unsigned char*)lds, g, S, E, nullptr); break; }
        case 3: case 9: case 12: {
            const int li = (s == 3) ? 0 : (s == 9 ? 1 : 2);
            float* dst = (s == 12 && d == DEPTH - 1) ? p.out : XF;
            phase_ln(Z, lng + li * D, lnb + li * D, dst, XB); break; }
        case 4: {
            pg8::Gemm g{XB, (const bf16_t*)(ws + WS_WIN), M, DINP, D}; pg8::StaticOrder S; S.init(M, DINP, gridDim.x, obid());
            pg8::EpiF32 E{U, DINP, nullptr}; pg8::gemm_phase<pg8::EpiF32, pg8::StaticOrder, false>((PG8_LAS unsigned char*)lds, g, S, E, nullptr); break; }
        case 5: phase_prep(p, d, (float*)lds); break;
        case 6: phase_scan(p, d); break;
        case 7: phase_post(p, d); break;
        }
        if (ph + 1 < p.ph_hi) grid.sync();
    }
}

extern "C" void kernel_launch(void* const* d_in, const int* in_sizes, int n_in, void* d_out, int out_size, void* d_ws, size_t ws_size, hipStream_t stream) {
    static int grid = 0;
    if (grid == 0) {
        if (n_in != 33 || (size_t)out_size != O_END || ws_size < WS_END) { fprintf(stderr, "kernel_launch: unexpected shapes: n_in %d out %d ws %zu (need %zu / %zu)\n", n_in, out_size, ws_size, (size_t)O_END, (size_t)WS_END); grid = -1; return; }
        int dev = 0, cus = 0, per_cu = 0;
        hipGetDevice(&dev); hipDeviceGetAttribute(&cus, hipDeviceAttributeMultiprocessorCount, dev);
        if (hipFuncSetAttribute((const void*)hybrid_fwd, hipFuncAttributeMaxDynamicSharedMemorySize, LDS_BYTES) != hipSuccess) { fprintf(stderr, "kernel_launch: hipFuncSetAttribute failed\n"); grid = -1; return; }
        if (hipOccupancyMaxActiveBlocksPerMultiprocessor(&per_cu, (const void*)hybrid_fwd, 512, LDS_BYTES) != hipSuccess || per_cu < 1) { fprintf(stderr, "kernel_launch: occupancy query says %d\n", per_cu); per_cu = 1; }
        (void)hipGetLastError();
        grid = cus * 1;
        if (grid <= 0) grid = 256;
    }
    if (grid < 0) return;
    (void)hipMemsetAsync((char*)d_ws + WS_CTL, 0, 4096, stream);
    Params p{};
    for (int i = 0; i < 33; ++i) p.in[i] = (const float*)d_in[i];
    p.out = (float*)d_out; p.ws = (unsigned char*)d_ws;
#if MULTI_LAUNCH
    for (int ph = 0; ph < NPH; ++ph) { p.ph_lo = ph; p.ph_hi = ph + 1; hipLaunchKernelGGL(hybrid_fwd, dim3(grid), dim3(512), LDS_BYTES, stream, p); }
#else
    p.ph_lo = 0; p.ph_hi = NPH;
    void* args[] = {&p};
    hipError_t e = hipLaunchCooperativeKernel((const void*)hybrid_fwd, dim3(grid), dim3(512), args, LDS_BYTES, stream);
    if (e != hipSuccess) fprintf(stderr, "cooperative launch failed: %s (grid %d)\n", hipGetErrorString(e), grid);
#endif
}
```

```cpp
#include <hip/hip_runtime.h>
#include <hip/hip_cooperative_groups.h>
#include <cstdio>
namespace cg = cooperative_groups;
#ifndef MULTI_LAUNCH
#define MULTI_LAUNCH 0
#endif
namespace pg8 {
#define PG8_LAS __attribute__((address_space(3)))
typedef unsigned short bf16_t;
typedef short bf16x8 __attribute__((ext_vector_type(8)));
typedef float f32x4 __attribute__((ext_vector_type(4)));
typedef unsigned u32x4 __attribute__((ext_vector_type(4)));
constexpr int BM = 256, BK = 64, HALF = 128, HTB = HALF * BK * 2  , STAGE_BYTES = 8 * HTB, NXCD = 8, WGM = 8;

__host__ __device__ __forceinline__ int lds_byte(int r, int c) { const int st = (r >> 4) * 2 + (c >> 5), rr = r & 15, cc = c & 31, ob = rr * 64 + cc * 2; return st * 1024 + (ob ^ (((ob >> 9) & 1) << 5)); }
__host__ __device__ __forceinline__ void stage_rc(int b, int& R, int& C) { const int st = b / 1024, sb = b % 1024, swz = sb ^ (((sb >> 9) & 1) << 5); R = (st >> 1) * 16 + swz / 64; C = (st & 1) * 32 + (swz % 64) / 2; }
__host__ __device__ __forceinline__ int perm32(int rho) { const int n = rho >> 4, i = rho & 15; return 8 * (i >> 2) + 4 * n + (i & 3); }

struct Unit { int pm, pn, ks, koff, nt; };
struct Gemm { const bf16_t* A; const bf16_t* Bt; int M, N, K, ld; };

struct StaticOrder {
    int nM, nN, nwg, G, c, ntf;
    __host__ __device__ void init(int M, int N, int G_, int c_, int K_) { nM = M / BM; nN = N / BM; nwg = nM * nN; G = G_; c = c_; ntf = K_ / BK; }
    __host__ __device__ void map(int wgid, Unit& u) const {
        { const int q = nwg / NXCD, r = nwg % NXCD, xcd = wgid % NXCD, off = wgid / NXCD; wgid = (xcd < r ? xcd * (q + 1) : r * (q + 1) + (xcd - r) * q) + off; }
        const int nig = WGM * nN, gid = wgid / nig, fm = gid * WGM, gsz = (nM - fm) < WGM ? (nM - fm) : WGM;
        u.pm = fm + ((wgid % nig) % gsz); u.pn = (wgid % nig) / gsz; u.ks = 0; u.koff = 0; u.nt = ntf; }
    __host__ __device__ bool next(int i, Unit& u) const {
        const long L = (long)i * G + c; if (L >= nwg) return false;
        map((int)L, u); return true;
    }
    __device__ __forceinline__ void a_ready(const Unit&) const {}
    __device__ __forceinline__ void done(const Unit&) const {}
};
__device__ __forceinline__ unsigned cvt_pk_bf16(float lo, float hi) { unsigned r; asm volatile("v_cvt_pk_bf16_f32 %0, %1, %2" : "=v"(r) : "v"(lo), "v"(hi)); return r; }
typedef float f32x2 __attribute__((ext_vector_type(2)));
struct EpiF32 {
    static constexpr bool PERM = false, AFTER_DRAIN = false;
    float* C; int ldc; const float* bias;
    __device__ __forceinline__ void operator()(const f32x4 (&acc)[2][2][4][2], const Unit& u, int wr, int wc, int fr, int fq) const {
        const int row0 = u.pm * BM + wr * 64 + fr, col0 = u.pn * BM + wc * 32 + 4 * fq;
        f32x4 bv[2][2];
#pragma unroll
        for (int bj = 0; bj < 2; ++bj)
#pragma unroll
            for (int n = 0; n < 2; ++n) bv[bj][n] = bias ? *(const f32x4*)(bias + col0 + bj * HALF + n * 16) : (f32x4){0.f, 0.f, 0.f, 0.f};
#pragma unroll
        for (int ai = 0; ai < 2; ++ai)
#pragma unroll
            for (int m = 0; m < 4; ++m) { float* rowp = C + (size_t)(row0 + ai * HALF + m * 16) * ldc + col0;
#pragma unroll
                for (int bj = 0; bj < 2; ++bj)
#pragma unroll
                    for (int n = 0; n < 2; ++n) *(f32x4*)(rowp + bj * HALF + n * 16) = acc[ai][bj][m][n] + bv[bj][n]; }
    }
};
template <class Epi, class Sched, bool STAMP = false>
__device__ __forceinline__ void gemm_phase(PG8_LAS unsigned char* lds, const Gemm g, const Sched& S, const Epi& E, unsigned long long* stamps) {
    int tid_ = threadIdx.x; asm volatile("" : "+v"(tid_));
    int K_ = g.K; asm volatile("" : "+s"(K_));
    const int tid = tid_, wid = __builtin_amdgcn_readfirstlane(tid >> 6), lane = tid & 63, wr = wid >> 2, wc = wid & 3, fr = lane & 15, fq = lane >> 4;
    const int K = K_, nt = K / BK; int ld_ = g.ld; asm volatile("" : "+s"(ld_)); const int ld = ld_;
    int ts_lo = 0, ts_hi = 0, nts = 0; const unsigned long long rt_entry = STAMP ? (unsigned long long)wall_clock64() : 0ull;
#define PG8_STAMP() do { if (STAMP && wid == 0 && nts < 64) { const unsigned long long _c = (unsigned long long)clock64(); \
        ts_lo = (lane == nts) ? (int)(unsigned)_c : ts_lo; ts_hi = (lane == nts) ? (int)(unsigned)(_c >> 32) : ts_hi; ++nts; } } while (0)
    PG8_STAMP();
    unsigned voffA[2], voffB[2];
#pragma unroll
    for (int i = 0; i < 2; ++i) { int R, C; stage_rc(tid * 16 + i * 8192, R, C); const int Rb = Epi::PERM ? ((R & ~31) + perm32(R & 31)) : R;
        voffA[i] = (unsigned)(R * ld + C) * 2u; voffB[i] = (unsigned)(Rb * ld + C) * 2u; }
    const size_t kstep = (size_t)(BK * 2);
    const size_t hstep = (size_t)HALF * ld * 2;
    const size_t tstep = 2 * hstep;
    const unsigned ldsw = (unsigned)wid * 1024u;
    const int aoff = lds_byte(wr * 64 + fr, fq * 8), boff = lds_byte(wc * 32 + fr, fq * 8);
#define PG8_SA(b, h) (((b) * 2 + (h)) * HTB)
#define PG8_SB(b, h) ((4 + (b) * 2 + (h)) * HTB)
#define PG8_STAGE(bufoff, gbase, voff) do { _Pragma("unroll") for (int _i = 0; _i < 2; ++_i) \
        __builtin_amdgcn_global_load_lds((const unsigned*)((const char*)(gbase) + (voff)[_i]), (PG8_LAS unsigned*)(lds + (bufoff) + ldsw + _i * 8192), 16, 0, 0); } while (0)
#define PG8_LDA(dst, b, h) do { _Pragma("unroll") for (int m = 0; m < 4; ++m) _Pragma("unroll") for (int k = 0; k < 2; ++k) dst[m][k] = *(const PG8_LAS bf16x8*)(lds + PG8_SA(b, h) + aoff + m * 2048 + k * 1024); } while (0)
#define PG8_LDB(dst, b, h) do { _Pragma("unroll") for (int n = 0; n < 2; ++n) _Pragma("unroll") for (int k = 0; k < 2; ++k) dst[n][k] = *(const PG8_LAS bf16x8*)(lds + PG8_SB(b, h) + boff + n * 2048 + k * 1024); } while (0)
#define PG8_MMA(ai, bj, At, Bt) do { __builtin_amdgcn_s_setprio(1); _Pragma("unroll") for (int m = 0; m < 4; ++m) _Pragma("unroll") for (int n = 0; n < 2; ++n) _Pragma("unroll") for (int k = 0; k < 2; ++k) \
        acc[ai][bj][m][n] = __builtin_amdgcn_mfma_f32_16x16x32_bf16(Bt[n][k], At[m][k], acc[ai][bj][m][n], 0, 0, 0); __builtin_amdgcn_s_setprio(0); } while (0)
#define PG8_WAIT_V(n) asm volatile("s_waitcnt vmcnt(" #n ")" ::: "memory")
#define PG8_WAIT_L(n) asm volatile("s_waitcnt lgkmcnt(" #n ")" ::: "memory")
#define PG8_BAR __builtin_amdgcn_s_barrier()
#define PG8_SCHED __builtin_amdgcn_sched_barrier(0)
    Unit cur, nxt; int ui = 0;
    if (!S.next(0, cur)) return;
    f32x4 acc[2][2][4][2];
#pragma unroll
    for (int a = 0; a < 2; ++a)
#pragma unroll
        for (int b = 0; b < 2; ++b)
#pragma unroll
            for (int m = 0; m < 4; ++m)
#pragma unroll
                for (int n = 0; n < 2; ++n) acc[a][b][m][n] = (f32x4){0.f, 0.f, 0.f, 0.f};
    bf16x8 At[4][2], B0[2][2], B1[2][2];
    const char* cA = (const char*)g.A + (size_t)cur.pm * tstep + (size_t)cur.koff; const char* cB = (const char*)g.Bt + (size_t)cur.pn * tstep + (size_t)cur.koff;
    S.a_ready(cur);
    PG8_STAGE(PG8_SB(0, 0), cB, voffB); PG8_STAGE(PG8_SA(0, 0), cA, voffA); PG8_STAGE(PG8_SB(0, 1), cB + hstep, voffB); PG8_STAGE(PG8_SA(0, 1), cA + hstep, voffA);
    if (wr == 1) PG8_BAR;
    PG8_WAIT_V(4); PG8_BAR;
    PG8_STAGE(PG8_SB(1, 0), cB + kstep, voffB); PG8_STAGE(PG8_SA(1, 0), cA + kstep, voffA); PG8_STAGE(PG8_SB(1, 1), cB + hstep + kstep, voffB);
    PG8_WAIT_V(6); PG8_BAR;
    PG8_STAMP();
    for (;;) {
        const bool has_next = S.next(ui + 1, nxt);
        const char* nA = has_next ? (const char*)g.A + (size_t)nxt.pm * tstep + (size_t)nxt.koff : cA; const char* nB = has_next ? (const char*)g.Bt + (size_t)nxt.pn * tstep + (size_t)nxt.koff : cB;
        const int ntc = cur.nt;
        for (int t = 0; t < ntc; t += 2) {
            const bool last = (t == ntc - 2);
            const char* a1 = cA + (size_t)(t + 1) * kstep;
            const char* a2 = last ? nA : cA + (size_t)(t + 2) * kstep; const char* b2 = last ? nB : cB + (size_t)(t + 2) * kstep;
            const char* a3 = a2 + kstep; const char* b3 = b2 + kstep;
            if (last && has_next) S.a_ready(nxt);
            PG8_LDB(B0, 0, 0); PG8_SCHED; PG8_LDA(At, 0, 0); PG8_STAGE(PG8_SA(1, 1), a1 + hstep, voffA);
            PG8_WAIT_L(8); PG8_BAR; PG8_WAIT_L(0); PG8_MMA(0, 0, At, B0); PG8_BAR; PG8_SCHED;
            PG8_LDB(B1, 0, 1); PG8_STAGE(PG8_SB(0, 0), b2, voffB);
            PG8_BAR; PG8_WAIT_L(0); PG8_MMA(0, 1, At, B1); PG8_BAR;
            PG8_LDA(At, 0, 1); PG8_STAGE(PG8_SA(0, 0), a2, voffA);
            PG8_BAR; PG8_WAIT_L(0); PG8_MMA(1, 0, At, B0); PG8_BAR; PG8_SCHED;
            PG8_STAGE(PG8_SB(0, 1), b2 + hstep, voffB);
            PG8_WAIT_V(6); PG8_BAR; PG8_MMA(1, 1, At, B1); PG8_BAR;
            PG8_LDB(B0, 1, 0); PG8_SCHED; PG8_LDA(At, 1, 0); PG8_STAGE(PG8_SA(0, 1), a2 + hstep, voffA);
            PG8_WAIT_L(8); PG8_BAR; PG8_WAIT_L(0); PG8_MMA(0, 0, At, B0); PG8_BAR; PG8_SCHED;
            PG8_LDB(B1, 1, 1); PG8_STAGE(PG8_SB(1, 0), b3, voffB);
            PG8_BAR; PG8_WAIT_L(0); PG8_MMA(0, 1, At, B1); PG8_BAR;
            PG8_LDA(At, 1, 1); PG8_STAGE(PG8_SA(1, 0), a3, voffA);
            PG8_BAR; PG8_WAIT_L(0); PG8_MMA(1, 0, At, B0); PG8_BAR; PG8_SCHED;
            PG8_STAGE(PG8_SB(1, 1), b3 + hstep, voffB);
            PG8_WAIT_V(6); PG8_BAR; PG8_MMA(1, 1, At, B1); PG8_BAR;
        }
        PG8_STAMP();
        if constexpr (!Epi::AFTER_DRAIN) { E(acc, cur, wr, wc, fr, fq); S.done(cur); }
        PG8_STAMP();
        if (!has_next) break;
#pragma unroll
        for (int a = 0; a < 2; ++a)
#pragma unroll
            for (int b = 0; b < 2; ++b)
#pragma unroll
                for (int m = 0; m < 4; ++m)
#pragma unroll
                    for (int n = 0; n < 2; ++n) acc[a][b][m][n] = (f32x4){0.f, 0.f, 0.f, 0.f};
        cur = nxt; cA = nA; cB = nB; ++ui;
    }
    PG8_WAIT_V(0);
    if (wr == 0) PG8_BAR;
    PG8_BAR;
    if constexpr (Epi::AFTER_DRAIN) { E.fused(acc, cur, wr, wc, fr, fq, lds, wid, lane); S.done(cur); }
    PG8_STAMP();
    if (STAMP && wid == 0) { stamps[lane] = lane < nts ? (((unsigned long long)(unsigned)ts_hi << 32) | (unsigned)ts_lo) : 0ull;
        if (lane == 62) stamps[62] = rt_entry; if (lane == 63) stamps[63] = (unsigned long long)wall_clock64(); }
#undef PG8_STAMP
#undef PG8_SA
#undef PG8_SB
#undef PG8_STAGE
#undef PG8_LDA
#undef PG8_LDB
#undef PG8_MMA
#undef PG8_WAIT_V
#undef PG8_WAIT_L
#undef PG8_BAR
#undef PG8_SCHED
}
}

using pg8::bf16_t; using pg8::f32x4; using pg8::u32x4;
typedef unsigned u32x2 __attribute__((ext_vector_type(2)));
typedef float f32x2v __attribute__((ext_vector_type(2)));
constexpr int D = 2048, DFF = 5632, NB = 4, SEQ = 2048, DEPTH = 2, SBAT = 128, ST = 4;
constexpr int MP = NB * SEQ, MS = SBAT * ST, M = MP + MS;
constexpr int NH = 6, HD = 128, QK = 768, GCONV = 2304, LW = 512, DIN = 7192, DINP = 7424, NGU = 2 * DFF;
constexpr int UZ = 2304, UMQ = 3072, UMK = 3840, UMV = 4608, UMO = 5376, ULX = 6144, ULY = 6656, UGB = 7168, UGA = 7174, UMI = 7180, UMF = 7186;
constexpr int UALD = 4864, UMLD = 2304, AZ = 2304, AMO = 3072, ALX = 3840, ALY = 4352;
constexpr size_t WS_UM_OFF = (size_t)128 << 20, WS_UG_OFF = (size_t)224 << 20;
constexpr float ALPHA = 1.41421356237f, EPS = 1e-6f;
constexpr int NPH_LAYER = 13, NPH = NPH_LAYER * DEPTH;
constexpr size_t O_YP = 0, O_YS = O_YP + (size_t)MP * D;
constexpr size_t SZ_PGS = (size_t)DEPTH * NB * NH * HD * HD, SZ_PGC = (size_t)DEPTH * NB * 3 * GCONV, SZ_PMN = (size_t)DEPTH * NB * NH * HD, SZ_PMM = (size_t)DEPTH * NB * NH, SZ_PLH = (size_t)DEPTH * NB * LW, SZ_PLC = (size_t)DEPTH * NB * 3 * LW;
constexpr size_t O_PGS = O_YS + (size_t)MS * D, O_PGC = O_PGS + SZ_PGS, O_PMC = O_PGC + SZ_PGC, O_PMN = O_PMC + SZ_PGS, O_PMM = O_PMN + SZ_PMN, O_PLH = O_PMM + SZ_PMM, O_PLC = O_PLH + SZ_PLH;
constexpr size_t SZ_SGS = (size_t)DEPTH * SBAT * NH * HD * HD, SZ_SGC = (size_t)DEPTH * SBAT * 3 * GCONV, SZ_SMN = (size_t)DEPTH * SBAT * NH * HD, SZ_SMM = (size_t)DEPTH * SBAT * NH, SZ_SLH = (size_t)DEPTH * SBAT * LW, SZ_SLC = (size_t)DEPTH * SBAT * 3 * LW;
constexpr size_t O_SGS = O_PLC + SZ_PLC, O_SGC = O_SGS + SZ_SGS, O_SMC = O_SGC + SZ_SGC, O_SMN = O_SMC + SZ_SGS, O_SMM = O_SMN + SZ_SMN, O_SLH = O_SMM + SZ_SMM, O_SLC = O_SLH + SZ_SLH, O_END = O_SLC + SZ_SLC;
constexpr int KS_MAX_WS = 11;
constexpr size_t al256(size_t x) { return (x + 255) & ~(size_t)255; }
constexpr size_t WS_CTL = 0, WS_BAR = 8192, WS_WGU1 = 32768, WS_WD1 = WS_WGU1 + (size_t)NGU * D * 2, WS_WIN = WS_WD1 + (size_t)D * DFF * 2, WS_WOUT = WS_WIN + (size_t)DINP * D * 2,
    WS_WGU2 = WS_WOUT + (size_t)D * D * 2, WS_WD2 = WS_WGU2 + (size_t)NGU * D * 2, WS_XF = WS_WD2 + (size_t)D * DFF * 2, WS_XB = WS_XF + (size_t)M * D * 4,
    WS_Z = WS_XB + (size_t)M * D * 2, WS_BIG = WS_Z + (size_t)M * D * 4, WS_GQ = WS_BIG + (size_t)M * DINP * 4, WS_GK = WS_GQ + (size_t)M * QK * 4, WS_GV = WS_GK + (size_t)M * QK * 4,
    WS_LA = WS_GV + (size_t)M * QK * 4, WS_LU = WS_LA + (size_t)M * LW * 4, WS_SC = WS_LU + (size_t)M * LW * 4, WS_MIX = WS_SC + (size_t)6 * M * 8 * 4, WS_PART = WS_MIX + (size_t)M * D * 2, WS_END = WS_PART + (size_t)KS_MAX_WS * MS * D * 4;

struct Params { const float* in[33]; float* out; unsigned char* ws; int ph_lo, ph_hi; };

#define AS1 __attribute__((address_space(1)))
template <class T> __device__ __forceinline__ T* as_global(T* q) { return (T*)(AS1 T*)q; }
__device__ __forceinline__ unsigned char* ows(const Params& p) { unsigned char* w = p.ws; asm volatile("" : "+s"(w)); return w; }
__device__ __forceinline__ float sigmoidf_(float x) { return __builtin_amdgcn_rcpf(1.0f + __expf(-x)); }
__device__ __forceinline__ float siluf_(float x) { return x * __builtin_amdgcn_rcpf(1.0f + __expf(-x)); }
__device__ __forceinline__ float softplusf_(float x) { const float e = __expf(-fabsf(x)); return fmaxf(x, 0.f) + (e < 1e-3f ? e * (1.0f - 0.5f * e) : __logf(1.0f + e)); }
__device__ __forceinline__ float silu_fast(float x) { return x * __builtin_amdgcn_rcpf(1.0f + __expf(-x)); }
template <int CTRL> __device__ __forceinline__ float dppf(float x) { return __builtin_bit_cast(float, __builtin_amdgcn_mov_dpp(__builtin_bit_cast(int, x), CTRL, 0xf, 0xf, true)); }
__device__ __forceinline__ float allreduce16(float x) { x += dppf<0xB1>(x); x += dppf<0x4E>(x); x += dppf<0x141>(x); x += dppf<0x128>(x); return x; }
__device__ __forceinline__ float rdl_(float v, int l) { return __builtin_bit_cast(float, __builtin_amdgcn_readlane(__builtin_bit_cast(int, v), l)); }
__device__ __forceinline__ float reduce32(float x) { x = allreduce16(x); const float lo = rdl_(x, 0) + rdl_(x, 16), hi = rdl_(x, 32) + rdl_(x, 48); return (threadIdx.x & 32) ? hi : lo; }
__device__ __forceinline__ float reduce64(float x) { x = allreduce16(x); return (rdl_(x, 0) + rdl_(x, 16)) + (rdl_(x, 32) + rdl_(x, 48)); }

__device__ __forceinline__ int otid() { int t = threadIdx.x; asm volatile("" : "+v"(t)); return t; }
__device__ __forceinline__ int obid() { int t = blockIdx.x; asm volatile("" : "+s"(t)); return t; }
struct EpiSwiglu {
    static constexpr bool PERM = true, AFTER_DRAIN = false;
    bf16_t* H; int ldh;
    __device__ __forceinline__ void operator()(const f32x4 (&acc)[2][2][4][2], const pg8::Unit& u, int wr, int wc, int fr, int fq) const {
        const int row0 = u.pm * 256 + wr * 64 + fr, col0 = u.pn * 128 + wc * 32 + 8 * fq;
#pragma unroll
        for (int ai = 0; ai < 2; ++ai)
#pragma unroll
            for (int m = 0; m < 4; ++m) {
                bf16_t* rowp = H + (size_t)(row0 + ai * 128 + m * 16) * ldh + col0;
                const f32x4 g0 = acc[ai][0][m][0], g1 = acc[ai][0][m][1], u0 = acc[ai][1][m][0], u1 = acc[ai][1][m][1];
                u32x4 w;
                w.x = pg8::cvt_pk_bf16(silu_fast(g0[0]) * u0[0], silu_fast(g0[1]) * u0[1]); w.y = pg8::cvt_pk_bf16(silu_fast(g0[2]) * u0[2], silu_fast(g0[3]) * u0[3]);
                w.z = pg8::cvt_pk_bf16(silu_fast(g1[0]) * u1[0], silu_fast(g1[1]) * u1[1]); w.w = pg8::cvt_pk_bf16(silu_fast(g1[2]) * u1[2], silu_fast(g1[3]) * u1[3]);
                *(u32x4*)rowp = w;
            }
    }
};
__device__ __forceinline__ float bf_lo(unsigned w) { return __uint_as_float(w << 16); }
__device__ __forceinline__ float bf_hi(unsigned w) { return __uint_as_float(w & 0xffff0000u); }
__device__ __forceinline__ f32x4 ld_bf4(const bf16_t* q) { const u32x2 w = *(const u32x2*)q; return (f32x4){bf_lo(w.x), bf_hi(w.x), bf_lo(w.y), bf_hi(w.y)}; }
struct EpiU {
    static constexpr bool PERM = true, AFTER_DRAIN = false;
    bf16_t* UA; float* UM; float* UG;
    __device__ __forceinline__ void operator()(const f32x4 (&acc)[2][2][4][2], const pg8::Unit& u, int wr, int wc, int fr, int fq) const {
        const int row0 = u.pm * 256 + wr * 64 + fr, cin = wc * 32 + 8 * fq;
        const int pn = u.pn;
#pragma unroll
        for (int ai = 0; ai < 2; ++ai)
#pragma unroll
            for (int m = 0; m < 4; ++m) {
                const size_t row = (size_t)(row0 + ai * 128 + m * 16);
#pragma unroll
                for (int bj = 0; bj < 2; ++bj) {
                    const f32x4 v0 = acc[ai][bj][m][0], v1 = acc[ai][bj][m][1]; const int c = pn * 256 + bj * 128 + cin;
                    if (pn < 12 || (pn >= 21 && pn < 28)) { u32x4 w; w.x = pg8::cvt_pk_bf16(v0[0], v0[1]); w.y = pg8::cvt_pk_bf16(v0[2], v0[3]); w.z = pg8::cvt_pk_bf16(v1[0], v1[1]); w.w = pg8::cvt_pk_bf16(v1[2], v1[3]);
                        *(u32x4*)(UA + row * UALD + (pn < 12 ? c : c - 2304)) = w; }
                    else if (pn < 21) { float* q = UM + row * UMLD + (c - 3072); *(f32x4*)q = v0; *(f32x4*)(q + 4) = v1; }
                    else if (bj == 0 && wc == 0) { float* q = UG + row * 32 + cin; *(f32x4*)q = v0; *(f32x4*)(q + 4) = v1; }
                }
            }
    }
};
struct EpiRes {
    static constexpr bool PERM = false, AFTER_DRAIN = false;
    const bf16_t* X; bf16_t* Z; int ld; float s;
    __device__ __forceinline__ void operator()(const f32x4 (&acc)[2][2][4][2], const pg8::Unit& u, int wr, int wc, int fr, int fq) const {
        const int row0 = u.pm * 256 + wr * 64 + fr, col0 = u.pn * 256 + wc * 32 + 4 * fq;
#pragma unroll
        for (int ai = 0; ai < 2; ++ai)
#pragma unroll
            for (int m = 0; m < 4; ++m) {
                const size_t off = (size_t)(row0 + ai * 128 + m * 16) * ld + col0;
#pragma unroll
                for (int bj = 0; bj < 2; ++bj)
#pragma unroll
                    for (int n = 0; n < 2; ++n) { const u32x2 xw = *(const u32x2*)(X + off + bj * 128 + n * 16);
                        const f32x4 xv = (f32x4){bf_lo(xw.x), bf_hi(xw.x), bf_lo(xw.y), bf_hi(xw.y)}, r = xv * ALPHA + acc[ai][bj][m][n] * s;
                        u32x2 w; w.x = pg8::cvt_pk_bf16(r[0], r[1]); w.y = pg8::cvt_pk_bf16(r[2], r[3]); *(u32x2*)(Z + off + bj * 128 + n * 16) = w; }
                asm volatile("" ::: "memory");
            }
    }
};

constexpr int KS_FFN = 4, KS_OUT = 4, KS_MAX = 4;
struct EpiPart {
    static constexpr bool PERM = false, AFTER_DRAIN = false;
    float* P;
    __device__ __forceinline__ void operator()(const f32x4 (&acc)[2][2][4][2], const pg8::Unit& u, int wr, int wc, int fr, int fq) const {
        const int row0 = u.pm * 256 + wr * 64 + fr, col0 = u.pn * 256 + wc * 32 + 4 * fq; float* base = P + (size_t)u.ks * MS * D;
#pragma unroll
        for (int ai = 0; ai < 2; ++ai)
#pragma unroll
            for (int m = 0; m < 4; ++m) {
                float* rowp = base + (size_t)(row0 + ai * 128 + m * 16) * D + col0;
#pragma unroll
                for (int bj = 0; bj < 2; ++bj)
#pragma unroll
                    for (int n = 0; n < 2; ++n) *(f32x4*)(rowp + bj * 128 + n * 16) = acc[ai][bj][m][n];
            }
    }
};
struct ResOrder : pg8::StaticOrder {
    int nks, ntsub, ksub_bytes;
    __device__ __forceinline__ bool next(int i, pg8::Unit& u) const {
        const long L = (long)i * G + c;
        if (L < nwg) { map((int)L, u); return true; }
        const int j = (int)(L - nwg); if (j >= 16 * nks) return false;
        const int t = (nks == KS_OUT) ? j / KS_OUT : j / KS_FFN;
        u.ks = j - t * nks; u.pm = (MP / 256) + (t >> 3); u.pn = t & 7; u.koff = u.ks * ksub_bytes; u.nt = ntsub; return true;
    }
};
struct EpiResPart {
    static constexpr bool PERM = false, AFTER_DRAIN = false;
    EpiRes r; EpiPart q;
    __device__ __forceinline__ void operator()(const f32x4 (&acc)[2][2][4][2], const pg8::Unit& u, int wr, int wc, int fr, int fq) const {
        if (u.pm < MP / 256) r(acc, u, wr, wc, fr, fq);
        else { pg8::Unit v = u; v.pm = u.pm - MP / 256; q(acc, v, wr, wc, fr, fq); }
    }
};
template <int MODE> __device__ __forceinline__ int map_row(int n) {
    if (MODE == 0) return n;
    if (MODE == 1) return 256 * (n >> 7) + (n & 127);
    if (MODE == 2) return 256 * (n >> 7) + 128 + (n & 127);
    if (n < 3072) return n;
    if (n < 3078) return UGB + (n - 3072);
    if (n < 3084) return UGA + (n - 3078);
    if (n < 6156) return n - 12;
    if (n < 6162) return UMI + (n - 6156);
    if (n < 6168) return UMF + (n - 6162);
    return n - 24;
}
constexpr int CT_LD = 260;
template <int MODE> __device__ __forceinline__ void convert_w(const float* __restrict__ W, int K, int N, bf16_t* __restrict__ Bt, float* tile, int t_begin, int t_end, int t_step) {
    const int tid = otid(), ntn = (N + 255) >> 8, ntiles = ntn * (K >> 6); if (t_end > ntiles) t_end = ntiles;
    for (int t = t_begin; t < t_end; t += t_step) {
        const int tk = t / ntn, tn = t - tk * ntn, k0 = tk * 64, n0 = tn * 256;
        { const int wv = tid >> 6, ln = tid & 63, n = n0 + ln * 4;
          f32x4 v[8];
#pragma unroll
          for (int i = 0; i < 8; ++i) v[i] = (n < N) ? *(const f32x4*)(W + (size_t)(k0 + wv + 8 * i) * N + n) : (f32x4){0.f, 0.f, 0.f, 0.f};
#pragma unroll
          for (int i = 0; i < 8; ++i) *(f32x4*)(tile + (wv + 8 * i) * CT_LD + ln * 4) = v[i]; }
        __syncthreads();
        { const int nn = tid & 255, kh = tid >> 8, n = n0 + nn;
          if (n < N) { const float* tp = tile + (kh * 32) * CT_LD + nn; bf16_t* dst = Bt + (size_t)map_row<MODE>(n) * K + k0 + kh * 32;
#pragma unroll
              for (int q = 0; q < 4; ++q) { u32x4 w;
                  w.x = pg8::cvt_pk_bf16(tp[(8 * q + 0) * CT_LD], tp[(8 * q + 1) * CT_LD]); w.y = pg8::cvt_pk_bf16(tp[(8 * q + 2) * CT_LD], tp[(8 * q + 3) * CT_LD]);
                  w.z = pg8::cvt_pk_bf16(tp[(8 * q + 4) * CT_LD], tp[(8 * q + 5) * CT_LD]); w.w = pg8::cvt_pk_bf16(tp[(8 * q + 6) * CT_LD], tp[(8 * q + 7) * CT_LD]);
                  *(u32x4*)(dst + 8 * q) = w; } } }
        __syncthreads();
    }
}
template <int MODE> __device__ __forceinline__ void tail_convert(const float* W, int K, int N, bf16_t* Bt, float* lds, int t0, int t1, int nbusy) {
    const int b0 = obid(), G = gridDim.x;
    if (G > nbusy) { if (b0 >= nbusy) convert_w<MODE>(W, K, N, Bt, lds, t0 + b0 - nbusy, t1, G - nbusy); }
    else convert_w<MODE>(W, K, N, Bt, lds, t0 + b0, t1, G);
}
constexpr int TC_A = 328, TC_B = 608;
__device__ __forceinline__ void phase_convert(const Params& p, int d, float* lds) {
    unsigned char* ws = ows(p);
    const int b0 = obid(), G = gridDim.x;
    if (d == 0) {
        convert_w<1>(p.in[9], D, DFF, (bf16_t*)(ws + WS_WGU1), lds, b0, 1 << 30, G);
        convert_w<2>(p.in[10], D, DFF, (bf16_t*)(ws + WS_WGU1), lds, b0, 1 << 30, G);
        convert_w<0>(p.in[11], DFF, D, (bf16_t*)(ws + WS_WD1), lds, b0, 1 << 30, G);
    }
    const size_t gt = (size_t)obid() * 512 + otid(), gn = (size_t)gridDim.x * 512;
    if (d == 0) {
        u32x4* zp = (u32x4*)((bf16_t*)(ws + WS_WIN) + (size_t)DIN * D);
        for (size_t i = gt; i < (size_t)(DINP - DIN) * D / 8; i += gn) zp[i] = (u32x4){0u, 0u, 0u, 0u};
        bf16_t* XB = (bf16_t*)(ws + WS_XB);
        for (size_t i = gt; i < (size_t)M * D / 4; i += gn) {
            const f32x4 v = (i < (size_t)MP * D / 4) ? ((const f32x4*)p.in[0])[i] : ((const f32x4*)p.in[1])[i - (size_t)MP * D / 4];
            u32x2 w; w.x = pg8::cvt_pk_bf16(v[0], v[1]); w.y = pg8::cvt_pk_bf16(v[2], v[3]); ((u32x2*)XB)[i] = w;
        }
    }
}

__device__ __forceinline__ void phase_ln(const bf16_t* Z, const bf16_t* XBold, const float* PART, int nks, float sres, const float* __restrict__ g, const float* __restrict__ b, float* OUTF, bf16_t* XB) {
    const int tid = otid(), lane = tid & 63, gw = obid() * 8 + (tid >> 6), nw = gridDim.x * 8;
    for (int row = gw; row < M; row += nw) {
        float v[4][8]; float s = 0.f;
#pragma unroll
        for (int i = 0; i < 4; ++i) {
            const int c8 = lane + 64 * i;
            const u32x4 w = ((const u32x4*)((row < MP ? Z : XBold) + (size_t)row * D))[c8];
            v[i][0] = bf_lo(w.x); v[i][1] = bf_hi(w.x); v[i][2] = bf_lo(w.y); v[i][3] = bf_hi(w.y); v[i][4] = bf_lo(w.z); v[i][5] = bf_hi(w.z); v[i][6] = bf_lo(w.w); v[i][7] = bf_hi(w.w);
            if (row >= MP) {
                const f32x4* pp = (const f32x4*)PART + (size_t)(row - MP) * (D / 4) + 2 * c8;
#pragma unroll
                for (int hh = 0; hh < 2; ++hh) { f32x4 ps = pp[hh];
                    for (int q = 1; q < nks; ++q) ps += pp[hh + (size_t)q * (MS * D / 4)];
#pragma unroll
                    for (int j = 0; j < 4; ++j) v[i][hh * 4 + j] = v[i][hh * 4 + j] * ALPHA + ps[j] * sres; }
            }
#pragma unroll
            for (int j = 0; j < 8; ++j) s += v[i][j];
        }
        s = reduce64(s); const float mu = s * (1.0f / D); float q = 0.f;
#pragma unroll
        for (int i = 0; i < 4; ++i)
#pragma unroll
            for (int j = 0; j < 8; ++j) { const float dd = v[i][j] - mu; q = fmaf(dd, dd, q); }
        q = reduce64(q); const float rs = rsqrtf(q * (1.0f / D) + EPS);
#pragma unroll
        for (int i = 0; i < 4; ++i) {
            const int c8 = lane + 64 * i; const f32x4 g0 = ((const f32x4*)g)[2 * c8], g1 = ((const f32x4*)g)[2 * c8 + 1], b0 = ((const f32x4*)b)[2 * c8], b1 = ((const f32x4*)b)[2 * c8 + 1];
            float o[8];
#pragma unroll
            for (int j = 0; j < 4; ++j) { o[j] = (v[i][j] - mu) * rs * g0[j] + b0[j]; o[4 + j] = (v[i][4 + j] - mu) * rs * g1[j] + b1[j]; }
            u32x4 w; w.x = pg8::cvt_pk_bf16(o[0], o[1]); w.y = pg8::cvt_pk_bf16(o[2], o[3]); w.z = pg8::cvt_pk_bf16(o[4], o[5]); w.w = pg8::cvt_pk_bf16(o[6], o[7]);
            ((u32x4*)(XB + (size_t)row * D))[c8] = w;
            if (OUTF) { ((f32x4*)(OUTF + (size_t)row * D))[2 * c8] = (f32x4){o[0], o[1], o[2], o[3]}; ((f32x4*)(OUTF + (size_t)row * D))[2 * c8 + 1] = (f32x4){o[4], o[5], o[6], o[7]}; }
        }
    }
}

struct RowInfo { int prompt, t, b, T; };
__device__ __forceinline__ RowInfo row_info(int r) { RowInfo ri; ri.prompt = r < MP; if (ri.prompt) { ri.t = r & (SEQ - 1); ri.b = r >> 11; ri.T = SEQ; } else { ri.t = (r - MP) & 3; ri.b = (r - MP) >> 2; ri.T = ST; } return ri; }
constexpr int TG = 17, NGRP = M / TG;
__device__ __forceinline__ void phase_prep(const Params& p, int d, float* lds) {
    unsigned char* ws = ows(p); const int tid = otid();
    const bf16_t* UA = (const bf16_t*)(ws + WS_BIG); const float* UG = (const float*)(ws + WS_BIG + WS_UG_OFF);
    float* GQ = (float*)(ws + WS_GQ); float* GK = (float*)(ws + WS_GK); float* GV = (float*)(ws + WS_GV);
    float* LA = (float*)(ws + WS_LA); float* LU = (float*)(ws + WS_LU);
    float* SCB = (float*)(ws + WS_SC); float* SCE = SCB + (size_t)M * 8; float* SCI = SCE + (size_t)M * 8; float* SCF = SCI + (size_t)M * 8;
    const float* gcw = p.in[15] + (size_t)d * 4 * GCONV; const float* A_log = p.in[16] + d * NH; const float* dtb = p.in[17] + d * NH;
    const float* ibias = p.in[19] + d * NH; const float* fbias = p.in[20] + d * NH;
    const float* lcw = p.in[22] + (size_t)d * 4 * LW; const float* lcb = p.in[23] + (size_t)d * LW;
    const float* wr = p.in[24] + (size_t)d * 8 * 64 * 64; const float* br = p.in[25] + (size_t)d * LW; const float* wi = p.in[26] + (size_t)d * 8 * 64 * 64; const float* bi = p.in[27] + (size_t)d * LW;
    const float* lam = p.in[28] + (size_t)d * LW;
    const float* sgc = p.in[3] + (size_t)d * SBAT * 3 * GCONV; const float* slc = p.in[8] + (size_t)d * SBAT * 3 * LW;
    float* o_pgc = p.out + O_PGC + (size_t)d * NB * 3 * GCONV; float* o_sgc = p.out + O_SGC + (size_t)d * SBAT * 3 * GCONV;
    float* o_plc = p.out + O_PLC + (size_t)d * NB * 3 * LW; float* o_slc = p.out + O_SLC + (size_t)d * SBAT * 3 * LW;
    float* cx = lds;
    for (int grp = obid(); grp < NGRP; grp += gridDim.x) {
        const int r0 = grp * TG;
        for (int it = 0; it < (TG * 576 + 511) / 512; it += 4) {
            f32x4 x3[4], xl[4][3], cw[4][4]; int rr[4], cc[4]; bool ok[4];
#pragma unroll
            for (int uu = 0; uu < 4; ++uu) {
                const int idx0 = tid + 512 * (it + uu); ok[uu] = idx0 < TG * 576; const int idx = ok[uu] ? idx0 : tid;
                const int tok = idx / 576, c = (idx - tok * 576) * 4, r = r0 + tok; const RowInfo ri = row_info(r); rr[uu] = r; cc[uu] = c;
                x3[uu] = ld_bf4(UA + (size_t)r * UALD + c);
#pragma unroll
                for (int L = 1; L <= 3; ++L) {
                    f32x4 v;
                    if (ri.t - L >= 0) v = ld_bf4(UA + (size_t)(r - L) * UALD + c);
                    else if (ri.prompt) v = (f32x4){0.f, 0.f, 0.f, 0.f};
                    else v = *(const f32x4*)(sgc + ((size_t)ri.b * 3 + (3 + ri.t - L)) * GCONV + c);
                    xl[uu][L - 1] = v;
                }
#pragma unroll
                for (int j = 0; j < 4; ++j) cw[uu][j] = *(const f32x4*)(gcw + j * GCONV + c);
            }
#pragma unroll
            for (int uu = 0; uu < 4; ++uu) {
                const int r = rr[uu], c = cc[uu]; const RowInfo ri = row_info(r);
                f32x4 y = cw[uu][0] * xl[uu][2] + cw[uu][1] * xl[uu][1] + cw[uu][2] * xl[uu][0] + cw[uu][3] * x3[uu];
#pragma unroll
                for (int j = 0; j < 4; ++j) y[j] = siluf_(y[j]);
                float ss = (y[0] * y[0] + y[1] * y[1]) + (y[2] * y[2] + y[3] * y[3]);
                ss = reduce32(ss);
                if (ok[uu]) {
                    if (c < QK) { *(f32x4*)(GQ + (size_t)r * QK + c) = y * (rsqrtf(ss + EPS) * 0.08838834764831845f); }
                    else if (c < 2 * QK) { *(f32x4*)(GK + (size_t)r * QK + (c - QK)) = y * rsqrtf(ss + EPS); }
                    else { *(f32x4*)(GV + (size_t)r * QK + (c - 2 * QK)) = y; }
                    if (ri.t >= ri.T - 3) { const int j = ri.t - (ri.T - 3); float* dst = ri.prompt ? o_pgc : o_sgc; *(f32x4*)(dst + ((size_t)ri.b * 3 + j) * GCONV + c) = x3[uu]; }
                }
            }
        }
        if (tid < TG * NH) {
            const int tok = tid / NH, h = tid - tok * NH, r = r0 + tok; const float* ur = UG + (size_t)r * 32 - UGB;
            const float beta = sigmoidf_(ur[UGB + h]);
            const float g = -expf(A_log[h]) * softplusf_(ur[UGA + h] + dtb[h]);
            SCB[(size_t)r * 8 + h] = beta; SCE[(size_t)r * 8 + h] = expf(g);
            SCI[(size_t)r * 8 + h] = ur[UMI + h] + ibias[h];
            SCF[(size_t)r * 8 + h] = -softplusf_(-(ur[UMF + h] + fbias[h]));
        }
        for (int idx = tid; idx < TG * 128; idx += 512) {
            const int tok = idx >> 7, c = (idx & 127) * 4, r = r0 + tok; const RowInfo ri = row_info(r);
            const f32x4 z4 = (f32x4){0.f, 0.f, 0.f, 0.f};
            const f32x4 x3 = ld_bf4(UA + (size_t)r * UALD + ALX + c);
            f32x4 xl[3];
#pragma unroll
            for (int L = 1; L <= 3; ++L) {
                f32x4 v;
                if (ri.t - L >= 0) v = ld_bf4(UA + (size_t)(r - L) * UALD + ALX + c);
                else if (ri.prompt) v = z4;
                else v = *(const f32x4*)(slc + ((size_t)ri.b * 3 + (3 + ri.t - L)) * LW + c);
                xl[L - 1] = v;
            }
            const f32x4 w0 = *(const f32x4*)(lcw + c), w1 = *(const f32x4*)(lcw + LW + c), w2 = *(const f32x4*)(lcw + 2 * LW + c), w3 = *(const f32x4*)(lcw + 3 * LW + c);
            const f32x4 y = w0 * xl[2] + w1 * xl[1] + w2 * xl[0] + w3 * x3 + *(const f32x4*)(lcb + c);
            *(f32x4*)(cx + tok * LW + c) = y;
            if (ri.t >= ri.T - 3) { const int j = ri.t - (ri.T - 3); float* dst = ri.prompt ? o_plc : o_slc; *(f32x4*)(dst + ((size_t)ri.b * 3 + j) * LW + c) = x3; }
        }
        __syncthreads();
        {
            int co = tid; asm volatile("" : "+v"(co));
            const int c = co, blk = c >> 6, e = c & 63;
            AS1 const float* wrp = (AS1 const float*)wr + (size_t)blk * 4096 + e; AS1 const float* wip = (AS1 const float*)wi + (size_t)blk * 4096 + e; const float* cxb = cx + blk * 64;
            f32x2v w2[64];
#pragma unroll
            for (int dd = 0; dd < 64; ++dd) { w2[dd][0] = wrp[dd * 64]; w2[dd][1] = wip[dd * 64]; }
            const float brv = br[c], biv = bi[c], spl = softplusf_(-lam[c]);
#pragma unroll 1
            for (int k = 0; k < TG; ++k) {
                f32x2v a0 = (f32x2v){0.f, 0.f}, a1 = a0, a2 = a0, a3 = a0;
#pragma unroll
                for (int hq = 0; hq < 2; ++hq) {
                f32x4 xv[16];
#pragma unroll
                for (int q = hq * 8; q < hq * 8 + 8; ++q) xv[q] = *(const f32x4*)(cxb + k * LW + q * 4);
#pragma unroll
                for (int q = hq * 8; q < hq * 8 + 8; ++q) { a0 = __builtin_elementwise_fma((f32x2v){xv[q][0], xv[q][0]}, w2[4 * q], a0); a1 = __builtin_elementwise_fma((f32x2v){xv[q][1], xv[q][1]}, w2[4 * q + 1], a1);
                    a2 = __builtin_elementwise_fma((f32x2v){xv[q][2], xv[q][2]}, w2[4 * q + 2], a2); a3 = __builtin_elementwise_fma((f32x2v){xv[q][3], xv[q][3]}, w2[4 * q + 3], a3); }
                }
                const f32x2v at = (a0 + a1) + (a2 + a3);
                const int r = r0 + k;
                const float rg = sigmoidf_(at[0] + brv), ig = sigmoidf_(at[1] + biv);
                const float log_a = -8.0f * rg * spl;
                LA[(size_t)r * LW + c] = __expf(log_a);
                LU[(size_t)r * LW + c] = __builtin_amdgcn_sqrtf(fmaxf(1.0f - __expf(2.0f * log_a), 0.f)) * (ig * cx[k * LW + c]);
            }
        }
        __syncthreads();
    }
}

template <int NC> struct GTok { f32x4 k0, k1, q0, q1; float v[NC]; float a, b; };
template <int NC> __device__ __forceinline__ void tok_load(GTok<NC>& t, const float* kp, const float* qp, const float* vp, const float* ap, const float* bp) {
    t.k0 = *(const f32x4*)kp; t.k1 = *(const f32x4*)(kp + 4); t.q0 = *(const f32x4*)qp; t.q1 = *(const f32x4*)(qp + 4);
    if (NC == 4) { const f32x4 vv = *(const f32x4*)vp; t.v[0] = vv[0]; t.v[NC > 1 ? 1 : 0] = vv[1]; t.v[NC > 2 ? 2 : 0] = vv[2]; t.v[NC > 3 ? 3 : 0] = vv[3]; }
    else {
#pragma unroll
        for (int j = 0; j < NC; ++j) t.v[j] = vp[j];
    }
    t.a = *ap; t.b = *bp;
}
template <int NC> __device__ __forceinline__ void store_nc(float* dst, const float (&o)[NC]) {
    if (NC == 4) *(f32x4*)dst = (f32x4){o[0], o[NC > 1 ? 1 : 0], o[NC > 2 ? 2 : 0], o[NC > 3 ? 3 : 0]};
    else {
#pragma unroll
        for (int j = 0; j < NC; ++j) dst[j] = o[j];
    }
}
template <int NC> __device__ __forceinline__ void gdn_step(float (&S)[8][NC], const GTok<NC>& t, float* orow, bool writer) {
    const float kk[8] = {t.k0[0], t.k0[1], t.k0[2], t.k0[3], t.k1[0], t.k1[1], t.k1[2], t.k1[3]};
    const float qq[8] = {t.q0[0], t.q0[1], t.q0[2], t.q0[3], t.q1[0], t.q1[1], t.q1[2], t.q1[3]};
    float u[NC], o[NC];
#pragma unroll
    for (int j = 0; j < NC; ++j) { float r = 0.f;
#pragma unroll
        for (int i = 0; i < 8; ++i) r = fmaf(S[i][j], kk[i], r);
        r = allreduce16(r); u[j] = t.a * (t.v[j] - t.b * r); }
#pragma unroll
    for (int j = 0; j < NC; ++j) { float a = 0.f;
#pragma unroll
        for (int i = 0; i < 8; ++i) { S[i][j] = fmaf(kk[i], u[j], t.b * S[i][j]); a = fmaf(S[i][j], qq[i], a); }
        o[j] = allreduce16(a); }
    if (writer) store_nc<NC>(orow, o);
}
template <int NC> __device__ __forceinline__ void mls_step(float (&C)[8][NC], float (&n)[8], float& m, const GTok<NC>& t, float* orow, bool writer) {
    const float kk[8] = {t.k0[0], t.k0[1], t.k0[2], t.k0[3], t.k1[0], t.k1[1], t.k1[2], t.k1[3]};
    const float qq[8] = {t.q0[0], t.q0[1], t.q0[2], t.q0[3], t.q1[0], t.q1[1], t.q1[2], t.q1[3]};
    const float mn = fmaxf(t.b + m, t.a), fd = expf(t.b + m - mn), iw = expf(t.a - mn) * 0.08838834764831845f; m = mn;
    float den = 0.f, kw[8];
#pragma unroll
    for (int i = 0; i < 8; ++i) { kw[i] = iw * kk[i]; n[i] = fmaf(fd, n[i], kw[i]); den = fmaf(n[i], qq[i], den); }
    den = allreduce16(den);
    const float inv = 1.0f / fmaxf(fabsf(den), expf(-mn));
    float o[NC];
#pragma unroll
    for (int j = 0; j < NC; ++j) { float a = 0.f;
#pragma unroll
        for (int i = 0; i < 8; ++i) { C[i][j] = fmaf(kw[i], t.v[j], fd * C[i][j]); a = fmaf(C[i][j], qq[i], a); }
        o[j] = allreduce16(a) * inv; }
    if (writer) store_nc<NC>(orow, o);
}

template <int NC, int KIND> __device__ __forceinline__ void mixer_item(const Params& p, int d, int prompt, int b, int h, int slab, int lane) {
    unsigned char* ws = ows(p);
    const int ks = lane & 15, cl = lane >> 4, cb = slab * (4 * NC) + cl * NC;
    const int T = prompt ? SEQ : ST, rbase = prompt ? b * SEQ : MP + b * ST;
    const float *kp, *qp, *vp, *ap, *bp; size_t kstride;
    if (KIND == 0) { kp = (const float*)(ws + WS_GK) + (size_t)rbase * QK + h * HD + 8 * ks; qp = (const float*)(ws + WS_GQ) + (size_t)rbase * QK + h * HD + 8 * ks; vp = (const float*)(ws + WS_GV) + (size_t)rbase * QK + h * HD + cb; kstride = QK;
        ap = (const float*)(ws + WS_SC) + (size_t)rbase * 8 + h; bp = ap + (size_t)M * 8; }
    else { const float* U = (const float*)(ws + WS_BIG + WS_UM_OFF) + (size_t)rbase * UMLD; kp = U + QK + h * HD + 8 * ks; qp = U + h * HD + 8 * ks; vp = U + 2 * QK + h * HD + cb; kstride = UMLD;
        ap = (const float*)(ws + WS_SC) + (size_t)2 * M * 8 + (size_t)rbase * 8 + h; bp = ap + (size_t)M * 8; }
    float* orow = (float*)(ws + WS_Z) + (size_t)rbase * D + (KIND == 0 ? 0 : QK) + h * HD + cb;
    const int nbatch = prompt ? NB : SBAT;
    const size_t sidx = ((size_t)(d * nbatch + b) * NH + h);
    float S[8][NC], n[8], m = 0.f;
#pragma unroll
    for (int i = 0; i < 8; ++i) { n[i] = 0.f;
#pragma unroll
        for (int j = 0; j < NC; ++j) S[i][j] = 0.f; }
    if (!prompt) {
        const float* S0 = p.in[KIND == 0 ? 2 : 4] + sidx * HD * HD + (size_t)(8 * ks) * HD + cb;
#pragma unroll
        for (int i = 0; i < 8; ++i) {
            if (NC == 4) { const f32x4 v = *(const f32x4*)(S0 + i * HD); S[i][0] = v[0]; S[i][NC > 1 ? 1 : 0] = v[1]; S[i][NC > 2 ? 2 : 0] = v[2]; S[i][NC > 3 ? 3 : 0] = v[3]; }
            else {
#pragma unroll
                for (int j = 0; j < NC; ++j) S[i][j] = S0[i * HD + j];
            }
        }
        if (KIND == 1) {
            const float* n0 = p.in[5] + sidx * HD + 8 * ks;
#pragma unroll
            for (int i = 0; i < 8; ++i) n[i] = n0[i];
            m = p.in[6][sidx];
        }
    }
    const bool writer = (ks == 0);
    GTok<NC> A[4], B[4];
    const int nblk = T >> 2;
#define LOADBLK(buf, blk) do { _Pragma("unroll") for (int q_ = 0; q_ < 4; ++q_) { const size_t t_ = (size_t)(blk) * 4 + q_; tok_load<NC>(buf[q_], kp + t_ * kstride, qp + t_ * kstride, vp + t_ * kstride, ap + t_ * 8, bp + t_ * 8); } } while (0)
#define COMPBLK(buf, blk) do { _Pragma("unroll") for (int q_ = 0; q_ < 4; ++q_) { const size_t t_ = (size_t)(blk) * 4 + q_; \
        if (KIND == 0) gdn_step<NC>(S, buf[q_], orow + t_ * D, writer); else mls_step<NC>(S, n, m, buf[q_], orow + t_ * D, writer); } } while (0)
    LOADBLK(A, 0);
    for (int blk = 0; blk < nblk; blk += 2) {
        if (blk + 1 < nblk) LOADBLK(B, blk + 1);
        COMPBLK(A, blk);
        if (blk + 1 < nblk) {
            if (blk + 2 < nblk) LOADBLK(A, blk + 2);
            COMPBLK(B, blk + 1);
        }
    }
#undef LOADBLK
#undef COMPBLK
    float* So = p.out + (KIND == 0 ? (prompt ? O_PGS : O_SGS) : (prompt ? O_PMC : O_SMC)) + sidx * HD * HD + (size_t)(8 * ks) * HD + cb;
#pragma unroll
    for (int i = 0; i < 8; ++i) { float tmp[NC];
#pragma unroll
        for (int j = 0; j < NC; ++j) tmp[j] = S[i][j];
        store_nc<NC>(So + i * HD, tmp); }
    if (KIND == 1 && slab == 0) {
        if (cl == 0) { float* no = p.out + (prompt ? O_PMN : O_SMN) + sidx * HD + 8 * ks;
#pragma unroll
            for (int i = 0; i < 8; ++i) no[i] = n[i]; }
        if (lane == 0) p.out[(prompt ? O_PMM : O_SMM) + sidx] = m;
    }
}
__device__ __forceinline__ void lru_item(const Params& p, int d, int prompt, int b, int grp, int lane) {
    unsigned char* ws = ows(p);
    const int c = grp * 64 + lane, T = prompt ? SEQ : ST, rbase = prompt ? b * SEQ : MP + b * ST;
    const float* la = (const float*)(ws + WS_LA) + (size_t)rbase * LW + c; const float* lu = (const float*)(ws + WS_LU) + (size_t)rbase * LW + c;
    float* orow = (float*)(ws + WS_Z) + (size_t)rbase * D + 2 * QK + c;
    float hst = prompt ? 0.f : p.in[7][((size_t)d * SBAT + b) * LW + c];
    for (int t = 0; t < T; t += 4) {
        float a[4], u[4];
#pragma unroll
        for (int q = 0; q < 4; ++q) { a[q] = la[(size_t)(t + q) * LW]; u[q] = lu[(size_t)(t + q) * LW]; }
#pragma unroll
        for (int q = 0; q < 4; ++q) { hst = fmaf(a[q], hst, u[q]); orow[(size_t)(t + q) * D] = hst; }
    }
    p.out[(prompt ? O_PLH : O_SLH) + ((size_t)d * (prompt ? NB : SBAT) + b) * LW + c] = hst;
}
constexpr int TCH = 32, LB_K = 0, LB_Q = TCH * 128, LB_V = 2 * TCH * 128, LB_AB = LB_V + TCH * 32, LB_SZ = LB_AB + TCH * 2, LB_ITEM = 2 * LB_SZ;
template <int CTRL> __device__ __forceinline__ float updpp(float oldv, float x) { return __builtin_bit_cast(float, __builtin_amdgcn_update_dpp(__builtin_bit_cast(int, oldv), __builtin_bit_cast(int, x), CTRL, 0xf, 0xf, false)); }
__device__ __forceinline__ float rdlane(float v, int l) { return __builtin_bit_cast(float, __builtin_amdgcn_readlane(__builtin_bit_cast(int, v), l)); }
template <int KIND> __device__ __forceinline__ void prompt_item(const Params& p, int d, int b, int h, int sg, float* lds) {
    unsigned char* ws = ows(p);
    const int tid = otid(), wave = tid >> 6, lane = tid & 63, ks = lane & 15, cl = lane >> 4, col = sg * 32 + wave * 4 + cl;
    const int rbase = b * SEQ;
    const float *kg, *qg, *vg, *ag, *bg; size_t kstride;
    if (KIND == 0) { kg = (const float*)(ws + WS_GK) + (size_t)rbase * QK + h * HD; qg = (const float*)(ws + WS_GQ) + (size_t)rbase * QK + h * HD; vg = (const float*)(ws + WS_GV) + (size_t)rbase * QK + h * HD + sg * 32; kstride = QK;
        ag = (const float*)(ws + WS_SC) + (size_t)rbase * 8 + h; bg = ag + (size_t)M * 8; }
    else { const float* U = (const float*)(ws + WS_BIG + WS_UM_OFF) + (size_t)rbase * UMLD; kg = U + QK + h * HD; qg = U + h * HD; vg = U + 2 * QK + h * HD + sg * 32; kstride = UMLD;
        ag = (const float*)(ws + WS_SC) + (size_t)2 * M * 8 + (size_t)rbase * 8 + h; bg = ag + (size_t)M * 8; }
    float* og = (float*)(ws + WS_Z) + (size_t)rbase * D + (KIND == 0 ? 0 : QK) + h * HD + col;
    AS1 const float *kG = (AS1 const float*)kg, *qG = (AS1 const float*)qg, *vG = (AS1 const float*)vg, *aG = (AS1 const float*)ag, *bG = (AS1 const float*)bg; AS1 float* oG = (AS1 float*)og;
    const int lt0 = tid >> 5, lf4 = tid & 31;
    const int lds_kq = (lf4 & 1) * 16 + (lf4 >> 1);
    const int vt = tid >> 3, vf4 = tid & 7;
    const int at = tid >> 1, aw = tid & 1;
    f32x4 kr0, kr1, qr0, qr1, vr; float abr = 0.f;
    vr = (f32x4){0.f, 0.f, 0.f, 0.f};
#define PI_LOAD(c) do { const size_t t0_ = (size_t)(c) * TCH; \
        kr0 = *(AS1 const f32x4*)(kG + (t0_ + lt0) * kstride + lf4 * 4); kr1 = *(AS1 const f32x4*)(kG + (t0_ + lt0 + 16) * kstride + lf4 * 4); \
        qr0 = *(AS1 const f32x4*)(qG + (t0_ + lt0) * kstride + lf4 * 4); qr1 = *(AS1 const f32x4*)(qG + (t0_ + lt0 + 16) * kstride + lf4 * 4); \
        if (tid < 256) vr = *(AS1 const f32x4*)(vG + (t0_ + vt) * kstride + vf4 * 4); \
        if (tid < 64) abr = (aw ? bG : aG)[(t0_ + at) * 8]; } while (0)
#define PI_STORE(buf) do { float* b_ = lds + (buf) * LB_SZ; \
        ((f32x4*)(b_ + LB_K))[lt0 * 32 + lds_kq] = kr0; ((f32x4*)(b_ + LB_K))[(lt0 + 16) * 32 + lds_kq] = kr1; \
        ((f32x4*)(b_ + LB_Q))[lt0 * 32 + lds_kq] = qr0; ((f32x4*)(b_ + LB_Q))[(lt0 + 16) * 32 + lds_kq] = qr1; \
        if (tid < 256) ((f32x4*)(b_ + LB_V))[vt * 8 + vf4] = vr; \
        if (tid < 64) b_[LB_AB + at * 2 + aw] = abr; } while (0)
    f32x2v S2[4], n2[4]; float mcar = 0.f;
#pragma unroll
    for (int i = 0; i < 4; ++i) { S2[i] = (f32x2v){0.f, 0.f}; n2[i] = (f32x2v){0.f, 0.f}; }
    const bool writer = (ks == 0);
    __syncthreads();
    PI_LOAD(0); PI_STORE(0);
    __syncthreads();
    constexpr int NCH = SEQ / TCH;
    for (int c = 0; c < NCH; ++c) {
        if (c + 1 < NCH) PI_LOAD(c + 1);
        const float* bf = lds + (c & 1) * LB_SZ;
        const int tl = lane & 31;
        float ga = bf[LB_AB + tl * 2], gb = bf[LB_AB + tl * 2 + 1], gc = 0.f;
        if (KIND == 1) {
            const float ip = ga, lf = gb;
            float cs = lf;
            cs += updpp<0x111>(0.f, cs); cs += updpp<0x112>(0.f, cs); cs += updpp<0x114>(0.f, cs); cs += updpp<0x118>(0.f, cs);
            { const float r0 = rdlane(cs, 15); if (lane & 16) cs += r0; }
            float pm = ip - cs;
            const float NINF = -3.0e38f;
            pm = fmaxf(pm, updpp<0x111>(NINF, pm)); pm = fmaxf(pm, updpp<0x112>(NINF, pm)); pm = fmaxf(pm, updpp<0x114>(NINF, pm)); pm = fmaxf(pm, updpp<0x118>(NINF, pm));
            { const float r0 = rdlane(pm, 15); if (lane & 16) pm = fmaxf(pm, r0); }
            const float mt = cs + fmaxf(mcar, pm);
            float mprev = updpp<0x111>(0.f, mt); { const float r0 = rdlane(mt, 15); if ((lane & 31) == 16) mprev = r0; }
            if (tl == 0) mprev = mcar;
            ga = __expf(lf + mprev - mt);
            gb = __expf(ip - mt) * 0.08838834764831845f;
            gc = __expf(-mt);
            mcar = rdlane(mt, 31);
        }
        AS1 float* orow = oG + (size_t)c * TCH * D;
        const f32x4* kb4 = (const f32x4*)(bf + LB_K) + ks; const f32x4* qb4 = (const f32x4*)(bf + LB_Q) + ks; const float* vb1 = bf + LB_V + wave * 4 + cl;
        f32x4 nk0 = kb4[0], nk1 = kb4[16], nq0 = qb4[0], nq1 = qb4[16]; float nv = vb1[0];
#pragma unroll 4
        for (int tt = 0; tt < TCH; ++tt) {
            const f32x4 k0 = nk0, k1 = nk1, q0 = nq0, q1 = nq1; const float v = nv;
            { const int tn = (tt + 1 < TCH) ? tt + 1 : tt;
              nk0 = kb4[tn * 32]; nk1 = kb4[tn * 32 + 16]; nq0 = qb4[tn * 32]; nq1 = qb4[tn * 32 + 16]; nv = vb1[tn * 32]; }
            const f32x2v k2[4] = {(f32x2v){k0[0], k0[1]}, (f32x2v){k0[2], k0[3]}, (f32x2v){k1[0], k1[1]}, (f32x2v){k1[2], k1[3]}};
            const f32x2v q2[4] = {(f32x2v){q0[0], q0[1]}, (f32x2v){q0[2], q0[3]}, (f32x2v){q1[0], q1[1]}, (f32x2v){q1[2], q1[3]}};
            const float sa = rdlane(ga, tt), sb = rdlane(gb, tt);
            if (KIND == 0) {
                f32x2v r2 = S2[0] * k2[0];
#pragma unroll
                for (int i = 1; i < 4; ++i) r2 = __builtin_elementwise_fma(S2[i], k2[i], r2);
                const float r = allreduce16(r2[0] + r2[1]);
                const float u = sa * (v - sb * r);
                f32x2v o2 = (f32x2v){0.f, 0.f};
#pragma unroll
                for (int i = 0; i < 4; ++i) { S2[i] = __builtin_elementwise_fma(S2[i], (f32x2v){sb, sb}, k2[i] * u); o2 = __builtin_elementwise_fma(S2[i], q2[i], o2); }
                const float o = allreduce16(o2[0] + o2[1]);
                orow[(size_t)tt * D] = o;
            } else {
                const float vs = v * sb;
                f32x2v o2 = (f32x2v){0.f, 0.f};
#pragma unroll
                for (int i = 0; i < 4; ++i) { S2[i] = __builtin_elementwise_fma(k2[i], (f32x2v){vs, vs}, S2[i] * sa); o2 = __builtin_elementwise_fma(S2[i], q2[i], o2); }
                const float num = allreduce16(o2[0] + o2[1]);
                orow[(size_t)tt * D] = num;
            }
        }
        if (c + 1 < NCH) PI_STORE((c + 1) & 1);
        __syncthreads();
    }
#undef PI_LOAD
#undef PI_STORE
    const size_t sidx = ((size_t)(d * NB + b) * NH + h);
    float* So = p.out + (KIND == 0 ? O_PGS : O_PMC) + sidx * HD * HD + (size_t)(8 * ks) * HD + col;
#pragma unroll
    for (int i = 0; i < 4; ++i) { So[(2 * i) * HD] = S2[i][0]; So[(2 * i + 1) * HD] = S2[i][1]; }
}
__device__ __forceinline__ void lru_prompt_item(const Params& p, int d, int b) {
    unsigned char* ws = ows(p);
    const int c = otid(), rbase = b * SEQ;
    const float* la = (const float*)(ws + WS_LA) + (size_t)rbase * LW + c; const float* lu = (const float*)(ws + WS_LU) + (size_t)rbase * LW + c;
    float* orow = (float*)(ws + WS_Z) + (size_t)rbase * D + 2 * QK + c;
    float hst = 0.f;
    constexpr int LB = 32, NBLK = SEQ / LB;
    float aA[LB], uA[LB], aB[LB], uB[LB];
#define LR_LOAD(a_, u_, blk) do { _Pragma("unroll") for (int q_ = 0; q_ < LB; ++q_) { a_[q_] = la[(size_t)((blk) * LB + q_) * LW]; u_[q_] = lu[(size_t)((blk) * LB + q_) * LW]; } } while (0)
#define LR_COMP(a_, u_, blk) do { _Pragma("unroll") for (int q_ = 0; q_ < LB; ++q_) { hst = fmaf(a_[q_], hst, u_[q_]); orow[(size_t)((blk) * LB + q_) * D] = hst; } } while (0)
    LR_LOAD(aA, uA, 0);
    for (int blk = 0; blk < NBLK; blk += 2) {
        LR_LOAD(aB, uB, blk + 1);
        LR_COMP(aA, uA, blk);
        if (blk + 2 < NBLK) LR_LOAD(aA, uA, blk + 2);
        LR_COMP(aB, uB, blk + 1);
    }
#undef LR_LOAD
#undef LR_COMP
    p.out[O_PLH + ((size_t)d * NB + b) * LW + c] = hst;
}
__device__ __forceinline__ void mden_item(const Params& p, int d, int b, int h, int lane) {
    unsigned char* ws = ows(p);
    const int rbase = b * SEQ, tl = lane & 31;
    AS1 const float* U = (AS1 const float*)((const float*)(ws + WS_BIG + WS_UM_OFF) + (size_t)rbase * UMLD);
    AS1 const float* kp = U + QK + h * HD + 2 * lane; AS1 const float* qp = U + h * HD + 2 * lane;
    AS1 const float* ipp = (AS1 const float*)((const float*)(ws + WS_SC) + (size_t)2 * M * 8 + (size_t)rbase * 8 + h); AS1 const float* lfp = ipp + (size_t)M * 8;
    AS1 float* deno = (AS1 float*)((float*)(ws + WS_SC) + (size_t)4 * M * 8 + (size_t)rbase * 8 + h); AS1 float* emo = deno + (size_t)M * 8;
    f32x2v n2 = (f32x2v){0.f, 0.f}; float mcar = 0.f, ga = 0.f, gb = 0.f;
    f32x2v kA[16], qA[16], kB[16], qB[16];
    constexpr int NHALF = SEQ / 16;
#define MD_LOAD(kk_, qq_, hh_) do { _Pragma("unroll") for (int j_ = 0; j_ < 16; ++j_) { const size_t t_ = (size_t)(hh_) * 16 + j_; kk_[j_] = *(AS1 const f32x2v*)(kp + t_ * UMLD); qq_[j_] = *(AS1 const f32x2v*)(qp + t_ * UMLD); } } while (0)
#define MD_COMP(kk_, qq_, hh_) do { float dv_ = 0.f; const int tb_ = ((hh_) & 1) * 16; \
        _Pragma("unroll") for (int j_ = 0; j_ < 16; ++j_) { const float sa_ = rdlane(ga, tb_ + j_), sb_ = rdlane(gb, tb_ + j_); \
            n2 = __builtin_elementwise_fma(n2, (f32x2v){sa_, sa_}, kk_[j_] * sb_); const f32x2v pr_ = n2 * qq_[j_]; \
            const float s_ = allreduce16(pr_[0] + pr_[1]); const float tot_ = (rdlane(s_, 0) + rdlane(s_, 16)) + (rdlane(s_, 32) + rdlane(s_, 48)); dv_ = (lane == j_) ? tot_ : dv_; } \
        if (lane < 16) deno[((size_t)(hh_) * 16 + lane) * 8] = dv_; } while (0)
#define MD_GATES(cc_) do { const float ip_ = ipn, lf_ = lfn; if ((cc_) + 1 < SEQ / 32) { ipn = ipp[((size_t)((cc_) + 1) * 32 + tl) * 8]; lfn = lfp[((size_t)((cc_) + 1) * 32 + tl) * 8]; } \
        float cs_ = lf_; cs_ += updpp<0x111>(0.f, cs_); cs_ += updpp<0x112>(0.f, cs_); cs_ += updpp<0x114>(0.f, cs_); cs_ += updpp<0x118>(0.f, cs_); \
        { const float r0_ = rdlane(cs_, 15); if (lane & 16) cs_ += r0_; } \
        float pm_ = ip_ - cs_; const float NI_ = -3.0e38f; \
        pm_ = fmaxf(pm_, updpp<0x111>(NI_, pm_)); pm_ = fmaxf(pm_, updpp<0x112>(NI_, pm_)); pm_ = fmaxf(pm_, updpp<0x114>(NI_, pm_)); pm_ = fmaxf(pm_, updpp<0x118>(NI_, pm_)); \
        { const float r0_ = rdlane(pm_, 15); if (lane & 16) pm_ = fmaxf(pm_, r0_); } \
        const float mt_ = cs_ + fmaxf(mcar, pm_); float mp_ = updpp<0x111>(0.f, mt_); { const float r0_ = rdlane(mt_, 15); if (tl == 16) mp_ = r0_; } if (tl == 0) mp_ = mcar; \
        ga = __expf(lf_ + mp_ - mt_); gb = __expf(ip_ - mt_) * 0.08838834764831845f; \
        if (lane < 32) emo[((size_t)(cc_) * 32 + tl) * 8] = __expf(-mt_); mcar = rdlane(mt_, 31); } while (0)
    float ipn = ipp[(size_t)tl * 8], lfn = lfp[(size_t)tl * 8];
    MD_LOAD(kA, qA, 0);
    for (int hh = 0; hh < NHALF; hh += 2) {
        MD_LOAD(kB, qB, hh + 1);
        MD_GATES(hh >> 1);
        MD_COMP(kA, qA, hh);
        if (hh + 2 < NHALF) MD_LOAD(kA, qA, hh + 2);
        MD_COMP(kB, qB, hh + 1);
    }
#undef MD_LOAD
#undef MD_COMP
#undef MD_GATES
    const size_t sidx = ((size_t)(d * NB + b) * NH + h);
    *(f32x2v*)(p.out + O_PMN + sidx * HD + 2 * lane) = n2;
    if (lane == 0) p.out[O_PMM + sidx] = mcar;
}
constexpr int CVT = 4, CV_OUT = (D / 256) * (D / 64) / CVT, CV_FF = (DFF / 256) * (D / 64) / CVT, CV_FD = (D / 256) * (DFF / 64) / CVT, CV_THIS = 2 * CV_FF + CV_FD, CV_GA = ((DFF / 256) * (D / 64) - TC_B) / CVT, CV_NEXT = CV_GA + CV_FF;
__device__ __forceinline__ void cv_item(const Params& p, int d, int j, float* lds) {
    unsigned char* ws = ows(p);
    __syncthreads();
    if (j < CV_FF) { convert_w<1>(p.in[30] + (size_t)d * D * DFF, D, DFF, (bf16_t*)(ws + WS_WGU2), lds, j * CVT, j * CVT + CVT, 1); return; }
    j -= CV_FF;
    if (j < CV_FF) { convert_w<2>(p.in[31] + (size_t)d * D * DFF, D, DFF, (bf16_t*)(ws + WS_WGU2), lds, j * CVT, j * CVT + CVT, 1); return; }
    j -= CV_FF;
    if (j < CV_FD) { convert_w<0>(p.in[32] + (size_t)d * DFF * D, DFF, D, (bf16_t*)(ws + WS_WD2), lds, j * CVT, j * CVT + CVT, 1); return; }
    j -= CV_FD;
    if (j < CV_GA) { convert_w<1>(p.in[9] + (size_t)(d + 1) * D * DFF, D, DFF, (bf16_t*)(ws + WS_WGU1), lds, TC_B + j * CVT, TC_B + j * CVT + CVT, 1); return; }
    j -= CV_GA;
    convert_w<2>(p.in[10] + (size_t)(d + 1) * D * DFF, D, DFF, (bf16_t*)(ws + WS_WGU1), lds, j * CVT, j * CVT + CVT, 1);
}
constexpr int IT_DN = 0, IT_GP = IT_DN + NB * NH / 8, IT_MP = IT_GP + NB * NH * 4, IT_LP = IT_MP + NB * NH * 4, IT_GS = IT_LP + NB, IT_MS = IT_GS + SBAT * NH, IT_LS = IT_MS + SBAT * NH, IT_END = IT_LS + SBAT;
__device__ __forceinline__ void phase_scan(const Params& p, int d, int rep, float* lds, int it_lo, int it_hi) {
    unsigned* ctr = (unsigned*)(ows(p) + WS_CTL) + 64 * (1 + d + 2 * rep);
    const int tid = otid(), lane = tid & 63, wave = tid >> 6;
    unsigned* slot = (unsigned*)(lds + LB_ITEM);
    for (;;) {
        __syncthreads();
        if (tid == 0) *slot = atomicAdd(ctr, 1u);
        __syncthreads();
        const unsigned it = (unsigned)__builtin_amdgcn_readfirstlane((int)*slot) + (unsigned)it_lo;
        if (it >= (unsigned)it_hi) break;
        if (it < (unsigned)IT_GP) { const int bh = it * 8 + wave; mden_item(p, d, bh / NH, bh % NH, lane); }
        else if (it < (unsigned)IT_MP) { const int x = it - IT_GP, bh = x >> 2; prompt_item<0>(p, d, bh / NH, bh % NH, x & 3, lds); }
        else if (it < (unsigned)IT_LP) { const int x = it - IT_MP, bh = x >> 2; prompt_item<1>(p, d, bh / NH, bh % NH, x & 3, lds); }
        else if (it < (unsigned)IT_GS) { lru_prompt_item(p, d, it - IT_LP); }
        else if (it < (unsigned)IT_MS) { const int bh = it - IT_GS; mixer_item<4, 0>(p, d, 0, bh / NH, bh % NH, wave, lane); }
        else if (it < (unsigned)IT_LS) { const int bh = it - IT_MS; mixer_item<4, 1>(p, d, 0, bh / NH, bh % NH, wave, lane); }
        else if (it < (unsigned)IT_END) { lru_item(p, d, 0, it - IT_LS, wave, lane); }
        else { cv_item(p, d, (int)it - IT_END, lds); }
    }
}

__device__ __forceinline__ float gelu_tanh(float y) { const float z = 0.7978845608028654f * (y + 0.044715f * y * y * y); return y * __builtin_amdgcn_rcpf(1.0f + __expf(-2.0f * z)); }
__device__ __forceinline__ void phase_post(const Params& p, int d) {
    unsigned char* ws = ows(p);
    const bf16_t* UA = (const bf16_t*)(ws + WS_BIG); const float* OR = (const float*)(ws + WS_Z); bf16_t* MIX = (bf16_t*)(ws + WS_MIX);
    const float* gnw = p.in[18] + (size_t)d * HD; const float* mnw = p.in[21] + (size_t)d * QK;
    const int tid = otid(), lane = tid & 63, gw = obid() * 8 + (tid >> 6), nw = gridDim.x * 8;
    for (int row = gw; row < M; row += nw) {
        const float* orow = OR + (size_t)row * D; const bf16_t* ur = UA + (size_t)row * UALD; bf16_t* mrow = MIX + (size_t)row * D;
#pragma unroll
        for (int i = 0; i < 3; ++i) {
            const int c = (lane + 64 * i) * 4;
            const f32x4 o = *(const f32x4*)(orow + c); float ss = (o[0] * o[0] + o[1] * o[1]) + (o[2] * o[2] + o[3] * o[3]); ss = reduce32(ss);
            const float rs = rsqrtf(ss * (1.0f / HD) + EPS); const f32x4 w = *(const f32x4*)(gnw + (c & 127)), z = ld_bf4(ur + AZ + c);
            float r[4];
#pragma unroll
            for (int j = 0; j < 4; ++j) r[j] = o[j] * rs * w[j] * siluf_(z[j]);
            u32x2 pk; pk.x = pg8::cvt_pk_bf16(r[0], r[1]); pk.y = pg8::cvt_pk_bf16(r[2], r[3]); *(u32x2*)(mrow + c) = pk;
        }
#pragma unroll
        for (int i = 0; i < 3; ++i) {
            const int c = (lane + 64 * i) * 4;
            f32x4 o = *(const f32x4*)(orow + QK + c);
            if (row < MP) { const float* scd = (const float*)(ws + WS_SC) + (size_t)4 * M * 8 + (size_t)row * 8 + (c >> 7); o = o * __builtin_amdgcn_rcpf(fmaxf(fabsf(scd[0]), scd[(size_t)M * 8])); }
            float ss = (o[0] * o[0] + o[1] * o[1]) + (o[2] * o[2] + o[3] * o[3]); ss = reduce32(ss);
            const float rs = rsqrtf(ss * (1.0f / HD) + EPS); const f32x4 w = *(const f32x4*)(mnw + c), z = ld_bf4(ur + AMO + c);
            float r[4];
#pragma unroll
            for (int j = 0; j < 4; ++j) r[j] = o[j] * rs * w[j] * sigmoidf_(z[j]);
            u32x2 pk; pk.x = pg8::cvt_pk_bf16(r[0], r[1]); pk.y = pg8::cvt_pk_bf16(r[2], r[3]); *(u32x2*)(mrow + QK + c) = pk;
        }
#pragma unroll
        for (int i = 0; i < 2; ++i) {
            const int c = (lane + 64 * i) * 4;
            const f32x4 o = *(const f32x4*)(orow + 2 * QK + c), y = ld_bf4(ur + ALY + c);
            float r[4];
#pragma unroll
            for (int j = 0; j < 4; ++j) r[j] = o[j] * gelu_tanh(y[j]);
            u32x2 pk; pk.x = pg8::cvt_pk_bf16(r[0], r[1]); pk.y = pg8::cvt_pk_bf16(r[2], r[3]); *(u32x2*)(mrow + 2 * QK + c) = pk;
        }
    }
}

#define XB_TMO      128
#define XB_XCNT(j)  (256  + 64 * (j))
#define XB_XSUB(j)  (1280 + 64 * (j))
#define XB_XGEN(j)  (2304 + 64 * (j))
#define XB_TOP      3328
#define XB_TOPGEN   3392
#define XCD_BAR_WORDS 3456
#define XB_SPIN_CAP (1u << 18)
#ifndef LAS
#define LAS __attribute__((address_space(3)))
#endif

__device__ __forceinline__ unsigned xb_ld(unsigned* p)              { return __hip_atomic_load(p, __ATOMIC_RELAXED, __HIP_MEMORY_SCOPE_AGENT); }
__device__ __forceinline__ unsigned xb_add(unsigned* p, unsigned v) { return __hip_atomic_fetch_add(p, v, __ATOMIC_RELAXED, __HIP_MEMORY_SCOPE_AGENT); }
__device__ __forceinline__ unsigned xb_xcc_id() { return (unsigned)__builtin_amdgcn_s_getreg((3 << 11) | 20) & 0xFu; }
#define XB_SPIN(cond, bar) do { unsigned _sp = 0; while (cond) { __builtin_amdgcn_s_sleep(1); \
    if ((++_sp & 255u) == 0u) { if (xb_ld(&(bar)[XB_TMO])) break; if (_sp > XB_SPIN_CAP) { atomicAdd(&(bar)[XB_TMO], 1u); break; } } } } while (0)

struct XcdBarrier {
    unsigned* bar; unsigned x;
    volatile LAS unsigned* st;
};

__device__ __forceinline__ XcdBarrier xcd_barrier_post(unsigned* bar, volatile LAS unsigned* st) {
    XcdBarrier b; b.bar = bar; b.x = xb_xcc_id(); b.st = st;
    if (threadIdx.x == 0) (void)xb_add(&bar[XB_XCNT(b.x)], 1u);
    return b;
}
__device__ __forceinline__ void xcd_barrier_complete(unsigned* bar, unsigned x, unsigned& nloc, unsigned& nx) {
    const unsigned G = gridDim.x * gridDim.y * gridDim.z;
    unsigned sum, cnt, mine, sp = 0u;
    for (;;) {
        sum = 0u; cnt = 0u; mine = 0u;
#pragma unroll
        for (unsigned j = 0; j < 16; ++j) { const unsigned c = xb_ld(&bar[XB_XCNT(j)]); sum += c; cnt += (c > 0u) ? 1u : 0u; mine = (j == x) ? c : mine; }
        if (sum == G) break;
        __builtin_amdgcn_s_sleep(1);
        if ((++sp & 255u) == 0u) { if (xb_ld(&bar[XB_TMO])) break; if (sp > XB_SPIN_CAP) { atomicAdd(&bar[XB_TMO], 1u); break; } }
    }
    nloc = mine > 0u ? mine : 1u; nx = cnt > 0u ? cnt : 1u;
}

__device__ __forceinline__ void xcd_barrier(const XcdBarrier& b) {
    asm volatile("s_waitcnt vmcnt(0)" ::: "memory");
    __syncthreads();
    if (threadIdx.x == 0) {
        unsigned* bar = b.bar;
        __builtin_amdgcn_s_waitcnt(0);
        unsigned nloc = b.st[0], nx = b.st[1];
        if (nloc == 0u) { xcd_barrier_complete(bar, b.x, nloc, nx); b.st[0] = nloc; b.st[1] = nx; }
        const unsigned old = xb_add(&bar[XB_XSUB(b.x)], 1u);
        const unsigned gen = old / nloc;
        if (old + 1u == (gen + 1u) * nloc) {
            __builtin_amdgcn_fence(__ATOMIC_RELEASE, "agent");
            asm volatile("s_waitcnt vmcnt(0)" ::: "memory");
            const unsigned og = xb_add(&bar[XB_TOP], 1u);
            const unsigned tg = og / nx;
            if (og + 1u == (tg + 1u) * nx) xb_add(&bar[XB_TOPGEN], 1u);
            else XB_SPIN(xb_ld(&bar[XB_TOPGEN]) == tg, bar);
            __builtin_amdgcn_fence(__ATOMIC_ACQUIRE, "agent");
            xb_add(&bar[XB_XGEN(b.x)], 1u);
            asm volatile("s_waitcnt vmcnt(0)" ::: "memory");
        } else {
            XB_SPIN(xb_ld(&bar[XB_XGEN(b.x)]) == gen, bar);
            __builtin_amdgcn_fence(__ATOMIC_ACQUIRE, "agent");
            asm volatile("s_waitcnt vmcnt(0)" ::: "memory");
        }
    }
    __syncthreads();
}
constexpr int LDS_BYTES = pg8::STAGE_BYTES + 16;
__global__ void __launch_bounds__(512) hybrid_fwd(Params p) {
    extern __shared__ __attribute__((aligned(16))) unsigned char lds[];
    cg::grid_group grid = cg::this_grid();
    volatile LAS unsigned* xst = (volatile LAS unsigned*)((LAS unsigned char*)lds + pg8::STAGE_BYTES);
    if (threadIdx.x == 0) { xst[0] = 0u; xst[1] = 0u; }
    __syncthreads();
    XcdBarrier xbar = xcd_barrier_post((unsigned*)(p.ws + WS_BAR), xst);
    for (int ph = p.ph_lo; ph < p.ph_hi; ++ph) {
        unsigned char* ws = ows(p);
        bf16_t* XB = (bf16_t*)(ws + WS_XB); bf16_t* Z = (bf16_t*)(ws + WS_Z);
        bf16_t* HB = (bf16_t*)(ws + WS_BIG); bf16_t* MIX = (bf16_t*)(ws + WS_MIX);
        const int d = ph / NPH_LAYER, s = ph - d * NPH_LAYER;
        if (s == 0 && d > 0) continue;
        const float* lng = p.in[12] + (size_t)d * 3 * D; const float* lnb = p.in[13] + (size_t)d * 3 * D;
#ifndef DBL_MASK
#define DBL_MASK 0
#endif
        for (int rep = 0; rep < (((DBL_MASK >> s) & 1) ? 2 : 1); ++rep) {
        if (rep) grid.sync();
        switch (s) {
        case 0: phase_convert(p, d, (float*)lds); break;
        case 1: case 10: {
            pg8::Gemm g{XB, (const bf16_t*)(ws + (s == 1 ? WS_WGU1 : WS_WGU2)), M, NGU, D, D}; pg8::StaticOrder S; S.init(M, NGU, gridDim.x, obid(), D);
            EpiSwiglu E{HB, DFF}; pg8::gemm_phase<EpiSwiglu, pg8::StaticOrder, false>((PG8_LAS unsigned char*)lds, g, S, E, nullptr);
            if (s == 10 && d + 1 < DEPTH) tail_convert<1>(p.in[9] + (size_t)(d + 1) * D * DFF, D, DFF, (bf16_t*)(ws + WS_WGU1), (float*)lds, TC_A, TC_B, ((M / 256) * (NGU / 256)) % (int)gridDim.x);
            break; }
        case 2: case 8: case 11: {
            const bf16_t* A = (s == 8) ? MIX : HB; const bf16_t* Bt = (const bf16_t*)(ws + (s == 2 ? WS_WD1 : (s == 8 ? WS_WOUT : WS_WD2)));
            const int Kf = (s == 8) ? D : DFF, nks = (s == 8) ? KS_OUT : KS_FFN, Ksub = (s == 8) ? D / KS_OUT : DFF / KS_FFN;
            pg8::Gemm g{A, Bt, MP, D, Kf, Kf}; ResOrder S; S.init(MP, D, gridDim.x, obid(), Kf); S.nks = nks; S.ntsub = Ksub / 64; S.ksub_bytes = Ksub * 2;
            EpiResPart E{EpiRes{XB, Z, D, (s == 8) ? 1.0f : 0.5f}, EpiPart{(float*)(ws + WS_PART)}};
            pg8::gemm_phase<EpiResPart, ResOrder, false>((PG8_LAS unsigned char*)lds, g, S, E, nullptr);
            if (s == 2) {
                const int nsub = 16 * KS_FFN, b0 = obid(), G = gridDim.x;
                if (G > nsub) { if (b0 >= nsub) convert_w<3>(p.in[14] + (size_t)d * D * DIN, D, DIN, (bf16_t*)(ws + WS_WIN), (float*)lds, b0 - nsub, 1 << 30, G - nsub); }
                else convert_w<3>(p.in[14] + (size_t)d * D * DIN, D, DIN, (bf16_t*)(ws + WS_WIN), (float*)lds, b0, 1 << 30, G);
            }
            if (s == 8 && d + 1 < DEPTH) tail_convert<1>(p.in[9] + (size_t)(d + 1) * D * DFF, D, DFF, (bf16_t*)(ws + WS_WGU1), (float*)lds, 0, TC_A, 16 * KS_OUT);
            if (s == 11 && d + 1 < DEPTH) {
                const int nsub = 16 * KS_FFN, b0 = obid(), G = gridDim.x;
                if (G > nsub) { if (b0 >= nsub) convert_w<0>(p.in[11] + (size_t)(d + 1) * DFF * D, DFF, D, (bf16_t*)(ws + WS_WD1), (float*)lds, b0 - nsub, 1 << 30, G - nsub); }
                else convert_w<0>(p.in[11] + (size_t)(d + 1) * DFF * D, DFF, D, (bf16_t*)(ws + WS_WD1), (float*)lds, b0, 1 << 30, G);
            }
            break; }
        case 3: case 9: case 12: {
            const int li = (s == 3) ? 0 : (s == 9 ? 1 : 2);
            float* dst = (s == 12 && d == DEPTH - 1) ? p.out : nullptr;
            phase_ln(Z, XB, (const float*)(ws + WS_PART), (s == 9) ? KS_OUT : KS_FFN, (s == 9) ? 1.0f : 0.5f, lng + li * D, lnb + li * D, dst, XB); break; }
        case 4: {
            pg8::Gemm g{XB, (const bf16_t*)(ws + WS_WIN), M, DINP, D, D}; pg8::StaticOrder S; S.init(M, DINP, gridDim.x, obid(), D);
            EpiU E{(bf16_t*)(ws + WS_BIG), (float*)(ws + WS_BIG + WS_UM_OFF), (float*)(ws + WS_BIG + WS_UG_OFF)}; pg8::gemm_phase<EpiU, pg8::StaticOrder, false>((PG8_LAS unsigned char*)lds, g, S, E, nullptr);
            tail_convert<0>(p.in[29] + (size_t)d * D * D, D, D, (bf16_t*)(ws + WS_WOUT), (float*)lds, 0, 1 << 30, ((M / 256) * (DINP / 256)) % (int)gridDim.x);
            break; }
        case 5: phase_prep(p, d, (float*)lds); break;
        #ifndef SCAN_PROBE
#define SCAN_PROBE 0
#endif
        case 6: phase_scan(p, d, 0, (float*)lds, 0, IT_END + CV_THIS + (d + 1 < DEPTH ? CV_NEXT : 0));
            if (SCAN_PROBE == 1) { grid.sync(); phase_scan(p, d, 1, (float*)lds, 0, IT_LP); }
            if (SCAN_PROBE == 2) { grid.sync(); phase_scan(p, d, 1, (float*)lds, IT_GS, IT_END); }
            if (SCAN_PROBE == 3) { grid.sync(); phase_scan(p, d, 1, (float*)lds, IT_LP, IT_GS); }
            break;
        case 7: phase_post(p, d); break;
        }
        }
        if (ph + 1 < p.ph_hi) { if (p.ph_hi < 0) grid.sync(); else xcd_barrier(xbar); }
    }
}

extern "C" void kernel_launch(void* const* d_in, const int* in_sizes, int n_in, void* d_out, int out_size, void* d_ws, size_t ws_size, hipStream_t stream) {
    static int grid = 0;
    if (grid == 0) {
        if (n_in != 33 || (size_t)out_size != O_END || ws_size < WS_END) { fprintf(stderr, "kernel_launch: unexpected shapes: n_in %d out %d ws %zu (need %zu / %zu)\n", n_in, out_size, ws_size, (size_t)O_END, (size_t)WS_END); grid = -1; return; }
        int dev = 0, cus = 0, per_cu = 0;
        hipGetDevice(&dev); hipDeviceGetAttribute(&cus, hipDeviceAttributeMultiprocessorCount, dev);
        if (hipFuncSetAttribute((const void*)hybrid_fwd, hipFuncAttributeMaxDynamicSharedMemorySize, LDS_BYTES) != hipSuccess) { fprintf(stderr, "kernel_launch: hipFuncSetAttribute failed\n"); grid = -1; return; }
        if (hipOccupancyMaxActiveBlocksPerMultiprocessor(&per_cu, (const void*)hybrid_fwd, 512, LDS_BYTES) != hipSuccess || per_cu < 1) { fprintf(stderr, "kernel_launch: occupancy query says %d\n", per_cu); per_cu = 1; }
        (void)hipGetLastError();
        grid = cus * 1;
        if (grid <= 0) grid = 256;
    }
    if (grid < 0) return;
    (void)hipMemsetAsync((char*)d_ws + WS_CTL, 0, 32768, stream);
    Params p{};
    for (int i = 0; i < 33; ++i) p.in[i] = (const float*)d_in[i];
    p.out = (float*)d_out; p.ws = (unsigned char*)d_ws;
#if MULTI_LAUNCH
    for (int ph = 0; ph < NPH; ++ph) { p.ph_lo = ph; p.ph_hi = ph + 1; hipLaunchKernelGGL(hybrid_fwd, dim3(grid), dim3(512), LDS_BYTES, stream, p); }
#else
    p.ph_lo = 0; p.ph_hi = NPH;
    void* args[] = {&p};
    hipError_t e = hipLaunchCooperativeKernel((const void*)hybrid_fwd, dim3(grid), dim3(512), args, LDS_BYTES, stream);
    if (e != hipSuccess) fprintf(stderr, "cooperative launch failed: %s (grid %d)\n", hipGetErrorString(e), grid);
#endif
}
```

```cpp
#include <hip/hip_runtime.h>
#include <hip/hip_cooperative_groups.h>
#include <cstdio>
namespace cg = cooperative_groups;
#ifndef MULTI_LAUNCH
#define MULTI_LAUNCH 0
#endif
namespace pg8 {
#define PG8_LAS __attribute__((address_space(3)))
typedef unsigned short bf16_t;
typedef short bf16x8 __attribute__((ext_vector_type(8)));
typedef float f32x4 __attribute__((ext_vector_type(4)));
typedef unsigned u32x4 __attribute__((ext_vector_type(4)));
constexpr int BM = 256, BK = 64, HALF = 128, HTB = HALF * BK * 2  , STAGE_BYTES = 8 * HTB, NXCD = 8, WGM = 8;

__host__ __device__ __forceinline__ int lds_byte(int r, int c) { const int st = (r >> 4) * 2 + (c >> 5), rr = r & 15, cc = c & 31, ob = rr * 64 + cc * 2; return st * 1024 + (ob ^ (((ob >> 9) & 1) << 5)); }
__host__ __device__ __forceinline__ void stage_rc(int b, int& R, int& C) { const int st = b / 1024, sb = b % 1024, swz = sb ^ (((sb >> 9) & 1) << 5); R = (st >> 1) * 16 + swz / 64; C = (st & 1) * 32 + (swz % 64) / 2; }
__host__ __device__ __forceinline__ int perm32(int rho) { const int n = rho >> 4, i = rho & 15; return 8 * (i >> 2) + 4 * n + (i & 3); }

struct Unit { int pm, pn, ks, koff, nt; };
struct Gemm { const bf16_t* A; const bf16_t* Bt; int M, N, K, ld; };

struct StaticOrder {
    int nM, nN, nwg, G, c, ntf;
    __host__ __device__ void init(int M, int N, int G_, int c_, int K_) { nM = M / BM; nN = N / BM; nwg = nM * nN; G = G_; c = c_; ntf = K_ / BK; }
    __host__ __device__ void map(int wgid, Unit& u) const {
        { const int q = nwg / NXCD, r = nwg % NXCD, xcd = wgid % NXCD, off = wgid / NXCD; wgid = (xcd < r ? xcd * (q + 1) : r * (q + 1) + (xcd - r) * q) + off; }
        const int nig = WGM * nN, gid = wgid / nig, fm = gid * WGM, gsz = (nM - fm) < WGM ? (nM - fm) : WGM;
        u.pm = fm + ((wgid % nig) % gsz); u.pn = (wgid % nig) / gsz; u.ks = 0; u.koff = 0; u.nt = ntf; }
    __host__ __device__ bool next(int i, Unit& u) const {
        const long L = (long)i * G + c; if (L >= nwg) return false;
        map((int)L, u); return true;
    }
    __device__ __forceinline__ void a_ready(const Unit&) const {}
    __device__ __forceinline__ void done(const Unit&) const {}
};
__device__ __forceinline__ unsigned cvt_pk_bf16(float lo, float hi) { unsigned r; asm volatile("v_cvt_pk_bf16_f32 %0, %1, %2" : "=v"(r) : "v"(lo), "v"(hi)); return r; }
typedef float f32x2 __attribute__((ext_vector_type(2)));
struct EpiF32 {
    static constexpr bool PERM = false, AFTER_DRAIN = false;
    float* C; int ldc; const float* bias;
    __device__ __forceinline__ void operator()(const f32x4 (&acc)[2][2][4][2], const Unit& u, int wr, int wc, int fr, int fq) const {
        const int row0 = u.pm * BM + wr * 64 + fr, col0 = u.pn * BM + wc * 32 + 4 * fq;
        f32x4 bv[2][2];
#pragma unroll
        for (int bj = 0; bj < 2; ++bj)
#pragma unroll
            for (int n = 0; n < 2; ++n) bv[bj][n] = bias ? *(const f32x4*)(bias + col0 + bj * HALF + n * 16) : (f32x4){0.f, 0.f, 0.f, 0.f};
#pragma unroll
        for (int ai = 0; ai < 2; ++ai)
#pragma unroll
            for (int m = 0; m < 4; ++m) { float* rowp = C + (size_t)(row0 + ai * HALF + m * 16) * ldc + col0;
#pragma unroll
                for (int bj = 0; bj < 2; ++bj)
#pragma unroll
                    for (int n = 0; n < 2; ++n) *(f32x4*)(rowp + bj * HALF + n * 16) = acc[ai][bj][m][n] + bv[bj][n]; }
    }
};
template <class Epi, class Sched, bool STAMP = false>
__device__ __forceinline__ void gemm_phase(PG8_LAS unsigned char* lds, const Gemm g, const Sched& S, const Epi& E, unsigned long long* stamps) {
    int tid_ = threadIdx.x; asm volatile("" : "+v"(tid_));
    int K_ = g.K; asm volatile("" : "+s"(K_));
    const int tid = tid_, wid = __builtin_amdgcn_readfirstlane(tid >> 6), lane = tid & 63, wr = wid >> 2, wc = wid & 3, fr = lane & 15, fq = lane >> 4;
    const int K = K_, nt = K / BK; int ld_ = g.ld; asm volatile("" : "+s"(ld_)); const int ld = ld_;
    int ts_lo = 0, ts_hi = 0, nts = 0; const unsigned long long rt_entry = STAMP ? (unsigned long long)wall_clock64() : 0ull;
#define PG8_STAMP() do { if (STAMP && wid == 0 && nts < 64) { const unsigned long long _c = (unsigned long long)clock64(); \
        ts_lo = (lane == nts) ? (int)(unsigned)_c : ts_lo; ts_hi = (lane == nts) ? (int)(unsigned)(_c >> 32) : ts_hi; ++nts; } } while (0)
    PG8_STAMP();
    unsigned voffA[2], voffB[2];
#pragma unroll
    for (int i = 0; i < 2; ++i) { int R, C; stage_rc(tid * 16 + i * 8192, R, C); const int Rb = Epi::PERM ? ((R & ~31) + perm32(R & 31)) : R;
        voffA[i] = (unsigned)(R * ld + C) * 2u; voffB[i] = (unsigned)(Rb * ld + C) * 2u; }
    const size_t kstep = (size_t)(BK * 2);
    const size_t hstep = (size_t)HALF * ld * 2;
    const size_t tstep = 2 * hstep;
    const unsigned ldsw = (unsigned)wid * 1024u;
    const int aoff = lds_byte(wr * 64 + fr, fq * 8), boff = lds_byte(wc * 32 + fr, fq * 8);
#define PG8_SA(b, h) (((b) * 2 + (h)) * HTB)
#define PG8_SB(b, h) ((4 + (b) * 2 + (h)) * HTB)
#define PG8_STAGE(bufoff, gbase, voff) do { _Pragma("unroll") for (int _i = 0; _i < 2; ++_i) \
        __builtin_amdgcn_global_load_lds((const unsigned*)((const char*)(gbase) + (voff)[_i]), (PG8_LAS unsigned*)(lds + (bufoff) + ldsw + _i * 8192), 16, 0, 0); } while (0)
#define PG8_LDA(dst, b, h) do { _Pragma("unroll") for (int m = 0; m < 4; ++m) _Pragma("unroll") for (int k = 0; k < 2; ++k) dst[m][k] = *(const PG8_LAS bf16x8*)(lds + PG8_SA(b, h) + aoff + m * 2048 + k * 1024); } while (0)
#define PG8_LDB(dst, b, h) do { _Pragma("unroll") for (int n = 0; n < 2; ++n) _Pragma("unroll") for (int k = 0; k < 2; ++k) dst[n][k] = *(const PG8_LAS bf16x8*)(lds + PG8_SB(b, h) + boff + n * 2048 + k * 1024); } while (0)
#define PG8_MMA(ai, bj, At, Bt) do { __builtin_amdgcn_s_setprio(1); _Pragma("unroll") for (int m = 0; m < 4; ++m) _Pragma("unroll") for (int n = 0; n < 2; ++n) _Pragma("unroll") for (int k = 0; k < 2; ++k) \
        acc[ai][bj][m][n] = __builtin_amdgcn_mfma_f32_16x16x32_bf16(Bt[n][k], At[m][k], acc[ai][bj][m][n], 0, 0, 0); __builtin_amdgcn_s_setprio(0); } while (0)
#define PG8_WAIT_V(n) asm volatile("s_waitcnt vmcnt(" #n ")" ::: "memory")
#define PG8_WAIT_L(n) asm volatile("s_waitcnt lgkmcnt(" #n ")" ::: "memory")
#define PG8_BAR __builtin_amdgcn_s_barrier()
#define PG8_SCHED __builtin_amdgcn_sched_barrier(0)
    Unit cur, nxt; int ui = 0;
    if (!S.next(0, cur)) return;
    f32x4 acc[2][2][4][2];
#pragma unroll
    for (int a = 0; a < 2; ++a)
#pragma unroll
        for (int b = 0; b < 2; ++b)
#pragma unroll
            for (int m = 0; m < 4; ++m)
#pragma unroll
                for (int n = 0; n < 2; ++n) acc[a][b][m][n] = (f32x4){0.f, 0.f, 0.f, 0.f};
    bf16x8 At[4][2], B0[2][2], B1[2][2];
    const char* cA = (const char*)g.A + (size_t)cur.pm * tstep + (size_t)cur.koff; const char* cB = (const char*)g.Bt + (size_t)cur.pn * tstep + (size_t)cur.koff;
    S.a_ready(cur);
    PG8_STAGE(PG8_SB(0, 0), cB, voffB); PG8_STAGE(PG8_SA(0, 0), cA, voffA); PG8_STAGE(PG8_SB(0, 1), cB + hstep, voffB); PG8_STAGE(PG8_SA(0, 1), cA + hstep, voffA);
    if (wr == 1) PG8_BAR;
    PG8_WAIT_V(4); PG8_BAR;
    PG8_STAGE(PG8_SB(1, 0), cB + kstep, voffB); PG8_STAGE(PG8_SA(1, 0), cA + kstep, voffA); PG8_STAGE(PG8_SB(1, 1), cB + hstep + kstep, voffB);
    PG8_WAIT_V(6); PG8_BAR;
    PG8_STAMP();
    for (;;) {
        const bool has_next = S.next(ui + 1, nxt);
        const char* nA = has_next ? (const char*)g.A + (size_t)nxt.pm * tstep + (size_t)nxt.koff : cA; const char* nB = has_next ? (const char*)g.Bt + (size_t)nxt.pn * tstep + (size_t)nxt.koff : cB;
        const int ntc = cur.nt;
        for (int t = 0; t < ntc; t += 2) {
            const bool last = (t == ntc - 2);
            const char* a1 = cA + (size_t)(t + 1) * kstep;
            const char* a2 = last ? nA : cA + (size_t)(t + 2) * kstep; const char* b2 = last ? nB : cB + (size_t)(t + 2) * kstep;
            const char* a3 = a2 + kstep; const char* b3 = b2 + kstep;
            if (last && has_next) S.a_ready(nxt);
            PG8_LDB(B0, 0, 0); PG8_SCHED; PG8_LDA(At, 0, 0); PG8_STAGE(PG8_SA(1, 1), a1 + hstep, voffA);
            PG8_WAIT_L(8); PG8_BAR; PG8_WAIT_L(0); PG8_MMA(0, 0, At, B0); PG8_BAR; PG8_SCHED;
            PG8_LDB(B1, 0, 1); PG8_STAGE(PG8_SB(0, 0), b2, voffB);
            PG8_BAR; PG8_WAIT_L(0); PG8_MMA(0, 1, At, B1); PG8_BAR;
            PG8_LDA(At, 0, 1); PG8_STAGE(PG8_SA(0, 0), a2, voffA);
            PG8_BAR; PG8_WAIT_L(0); PG8_MMA(1, 0, At, B0); PG8_BAR; PG8_SCHED;
            PG8_STAGE(PG8_SB(0, 1), b2 + hstep, voffB);
            PG8_WAIT_V(6); PG8_BAR; PG8_MMA(1, 1, At, B1); PG8_BAR;
            PG8_LDB(B0, 1, 0); PG8_SCHED; PG8_LDA(At, 1, 0); PG8_STAGE(PG8_SA(0, 1), a2 + hstep, voffA);
            PG8_WAIT_L(8); PG8_BAR; PG8_WAIT_L(0); PG8_MMA(0, 0, At, B0); PG8_BAR; PG8_SCHED;
            PG8_LDB(B1, 1, 1); PG8_STAGE(PG8_SB(1, 0), b3, voffB);
            PG8_BAR; PG8_WAIT_L(0); PG8_MMA(0, 1, At, B1); PG8_BAR;
            PG8_LDA(At, 1, 1); PG8_STAGE(PG8_SA(1, 0), a3, voffA);
            PG8_BAR; PG8_WAIT_L(0); PG8_MMA(1, 0, At, B0); PG8_BAR; PG8_SCHED;
            PG8_STAGE(PG8_SB(1, 1), b3 + hstep, voffB);
            PG8_WAIT_V(6); PG8_BAR; PG8_MMA(1, 1, At, B1); PG8_BAR;
        }
        PG8_STAMP();
        if constexpr (!Epi::AFTER_DRAIN) { E(acc, cur, wr, wc, fr, fq); S.done(cur); }
        PG8_STAMP();
        if (!has_next) break;
#pragma unroll
        for (int a = 0; a < 2; ++a)
#pragma unroll
            for (int b = 0; b < 2; ++b)
#pragma unroll
                for (int m = 0; m < 4; ++m)
#pragma unroll
                    for (int n = 0; n < 2; ++n) acc[a][b][m][n] = (f32x4){0.f, 0.f, 0.f, 0.f};
        cur = nxt; cA = nA; cB = nB; ++ui;
    }
    PG8_WAIT_V(0);
    if (wr == 0) PG8_BAR;
    PG8_BAR;
    if constexpr (Epi::AFTER_DRAIN) { E.fused(acc, cur, wr, wc, fr, fq, lds, wid, lane); S.done(cur); }
    PG8_STAMP();
    if (STAMP && wid == 0) { stamps[lane] = lane < nts ? (((unsigned long long)(unsigned)ts_hi << 32) | (unsigned)ts_lo) : 0ull;
        if (lane == 62) stamps[62] = rt_entry; if (lane == 63) stamps[63] = (unsigned long long)wall_clock64(); }
#undef PG8_STAMP
#undef PG8_SA
#undef PG8_SB
#undef PG8_STAGE
#undef PG8_LDA
#undef PG8_LDB
#undef PG8_MMA
#undef PG8_WAIT_V
#undef PG8_WAIT_L
#undef PG8_BAR
#undef PG8_SCHED
}
}

using pg8::bf16_t; using pg8::f32x4; using pg8::u32x4;
typedef unsigned u32x2 __attribute__((ext_vector_type(2)));
typedef float f32x2v __attribute__((ext_vector_type(2)));
constexpr int D = 2048, DFF = 5632, NB = 4, SEQ = 2048, DEPTH = 2, SBAT = 128, ST = 4;
constexpr int MP = NB * SEQ, MS = SBAT * ST, M = MP + MS;
constexpr int NH = 6, HD = 128, QK = 768, GCONV = 2304, LW = 512, DIN = 7192, DINP = 7424, NGU = 2 * DFF;
constexpr int UZ = 2304, UMQ = 3072, UMK = 3840, UMV = 4608, UMO = 5376, ULX = 6144, ULY = 6656, UGB = 7168, UGA = 7174, UMI = 7180, UMF = 7186;
constexpr int UALD = 4864, UMLD = 2304, AZ = 2304, AMO = 3072, ALX = 3840, ALY = 4352;
constexpr size_t WS_UM_OFF = (size_t)128 << 20, WS_UG_OFF = (size_t)224 << 20;
constexpr float ALPHA = 1.41421356237f, EPS = 1e-6f;
constexpr int NPH_LAYER = 13, NPH = NPH_LAYER * DEPTH;
constexpr size_t O_YP = 0, O_YS = O_YP + (size_t)MP * D;
constexpr size_t SZ_PGS = (size_t)DEPTH * NB * NH * HD * HD, SZ_PGC = (size_t)DEPTH * NB * 3 * GCONV, SZ_PMN = (size_t)DEPTH * NB * NH * HD, SZ_PMM = (size_t)DEPTH * NB * NH, SZ_PLH = (size_t)DEPTH * NB * LW, SZ_PLC = (size_t)DEPTH * NB * 3 * LW;
constexpr size_t O_PGS = O_YS + (size_t)MS * D, O_PGC = O_PGS + SZ_PGS, O_PMC = O_PGC + SZ_PGC, O_PMN = O_PMC + SZ_PGS, O_PMM = O_PMN + SZ_PMN, O_PLH = O_PMM + SZ_PMM, O_PLC = O_PLH + SZ_PLH;
constexpr size_t SZ_SGS = (size_t)DEPTH * SBAT * NH * HD * HD, SZ_SGC = (size_t)DEPTH * SBAT * 3 * GCONV, SZ_SMN = (size_t)DEPTH * SBAT * NH * HD, SZ_SMM = (size_t)DEPTH * SBAT * NH, SZ_SLH = (size_t)DEPTH * SBAT * LW, SZ_SLC = (size_t)DEPTH * SBAT * 3 * LW;
constexpr size_t O_SGS = O_PLC + SZ_PLC, O_SGC = O_SGS + SZ_SGS, O_SMC = O_SGC + SZ_SGC, O_SMN = O_SMC + SZ_SGS, O_SMM = O_SMN + SZ_SMN, O_SLH = O_SMM + SZ_SMM, O_SLC = O_SLH + SZ_SLH, O_END = O_SLC + SZ_SLC;
constexpr int KS_MAX_WS = 11;
constexpr size_t al256(size_t x) { return (x + 255) & ~(size_t)255; }
constexpr size_t WS_CTL = 0, WS_BAR = 8192, WS_WGU1 = 32768, WS_WD1 = WS_WGU1 + (size_t)NGU * D * 2, WS_WIN = WS_WD1 + (size_t)D * DFF * 2, WS_WOUT = WS_WIN + (size_t)DINP * D * 2,
    WS_WGU2 = WS_WOUT + (size_t)D * D * 2, WS_WD2 = WS_WGU2 + (size_t)NGU * D * 2, WS_XF = WS_WD2 + (size_t)D * DFF * 2, WS_XB = WS_XF + (size_t)M * D * 4,
    WS_Z = WS_XB + (size_t)M * D * 2, WS_BIG = WS_Z + (size_t)M * D * 4, WS_GQ = WS_BIG + (size_t)M * DINP * 4, WS_GK = WS_GQ + (size_t)M * QK * 4, WS_GV = WS_GK + (size_t)M * QK * 4,
    WS_LA = WS_GV + (size_t)M * QK * 4, WS_LU = WS_LA + (size_t)M * LW * 4, WS_SC = WS_LU + (size_t)M * LW * 4, WS_MIX = WS_SC + (size_t)6 * M * 8 * 4, WS_PART = WS_MIX + (size_t)M * D * 2, WS_END = WS_PART + (size_t)KS_MAX_WS * MS * D * 4;

struct Params { const float* in[33]; float* out; unsigned char* ws; int ph_lo, ph_hi; };

#define AS1 __attribute__((address_space(1)))
template <class T> __device__ __forceinline__ T* as_global(T* q) { return (T*)(AS1 T*)q; }
__device__ __forceinline__ unsigned char* ows(const Params& p) { unsigned char* w = p.ws; asm volatile("" : "+s"(w)); return w; }
__device__ __forceinline__ float sigmoidf_(float x) { return __builtin_amdgcn_rcpf(1.0f + __expf(-x)); }
__device__ __forceinline__ float siluf_(float x) { return x * __builtin_amdgcn_rcpf(1.0f + __expf(-x)); }
__device__ __forceinline__ float softplusf_(float x) { const float e = __expf(-fabsf(x)); return fmaxf(x, 0.f) + (e < 1e-3f ? e * (1.0f - 0.5f * e) : __logf(1.0f + e)); }
__device__ __forceinline__ float silu_fast(float x) { return x * __builtin_amdgcn_rcpf(1.0f + __expf(-x)); }
template <int CTRL> __device__ __forceinline__ float dppf(float x) { return __builtin_bit_cast(float, __builtin_amdgcn_mov_dpp(__builtin_bit_cast(int, x), CTRL, 0xf, 0xf, true)); }
__device__ __forceinline__ float allreduce16(float x) { x += dppf<0xB1>(x); x += dppf<0x4E>(x); x += dppf<0x141>(x); x += dppf<0x128>(x); return x; }
__device__ __forceinline__ float rdl_(float v, int l) { return __builtin_bit_cast(float, __builtin_amdgcn_readlane(__builtin_bit_cast(int, v), l)); }
__device__ __forceinline__ float reduce32(float x) { x = allreduce16(x); const float lo = rdl_(x, 0) + rdl_(x, 16), hi = rdl_(x, 32) + rdl_(x, 48); return (threadIdx.x & 32) ? hi : lo; }
__device__ __forceinline__ float reduce64(float x) { x = allreduce16(x); return (rdl_(x, 0) + rdl_(x, 16)) + (rdl_(x, 32) + rdl_(x, 48)); }

__device__ __forceinline__ int otid() { int t = threadIdx.x; asm volatile("" : "+v"(t)); return t; }
__device__ __forceinline__ int obid() { int t = blockIdx.x; asm volatile("" : "+s"(t)); return t; }
struct EpiSwiglu {
    static constexpr bool PERM = true, AFTER_DRAIN = false;
    bf16_t* H; int ldh;
    __device__ __forceinline__ void operator()(const f32x4 (&acc)[2][2][4][2], const pg8::Unit& u, int wr, int wc, int fr, int fq) const {
        const int row0 = u.pm * 256 + wr * 64 + fr, col0 = u.pn * 128 + wc * 32 + 8 * fq;
#pragma unroll
        for (int ai = 0; ai < 2; ++ai)
#pragma unroll
            for (int m = 0; m < 4; ++m) {
                bf16_t* rowp = H + (size_t)(row0 + ai * 128 + m * 16) * ldh + col0;
                const f32x4 g0 = acc[ai][0][m][0], g1 = acc[ai][0][m][1], u0 = acc[ai][1][m][0], u1 = acc[ai][1][m][1];
                u32x4 w;
                w.x = pg8::cvt_pk_bf16(silu_fast(g0[0]) * u0[0], silu_fast(g0[1]) * u0[1]); w.y = pg8::cvt_pk_bf16(silu_fast(g0[2]) * u0[2], silu_fast(g0[3]) * u0[3]);
                w.z = pg8::cvt_pk_bf16(silu_fast(g1[0]) * u1[0], silu_fast(g1[1]) * u1[1]); w.w = pg8::cvt_pk_bf16(silu_fast(g1[2]) * u1[2], silu_fast(g1[3]) * u1[3]);
                *(u32x4*)rowp = w;
            }
    }
};
__device__ __forceinline__ float bf_lo(unsigned w) { return __uint_as_float(w << 16); }
__device__ __forceinline__ float bf_hi(unsigned w) { return __uint_as_float(w & 0xffff0000u); }
__device__ __forceinline__ f32x4 ld_bf4(const bf16_t* q) { const u32x2 w = *(const u32x2*)q; return (f32x4){bf_lo(w.x), bf_hi(w.x), bf_lo(w.y), bf_hi(w.y)}; }
struct EpiU {
    static constexpr bool PERM = true, AFTER_DRAIN = false;
    bf16_t* UA; float* UM; float* UG;
    __device__ __forceinline__ void operator()(const f32x4 (&acc)[2][2][4][2], const pg8::Unit& u, int wr, int wc, int fr, int fq) const {
        const int row0 = u.pm * 256 + wr * 64 + fr, cin = wc * 32 + 8 * fq;
        const int pn = u.pn;
#pragma unroll
        for (int ai = 0; ai < 2; ++ai)
#pragma unroll
            for (int m = 0; m < 4; ++m) {
                const size_t row = (size_t)(row0 + ai * 128 + m * 16);
#pragma unroll
                for (int bj = 0; bj < 2; ++bj) {
                    const f32x4 v0 = acc[ai][bj][m][0], v1 = acc[ai][bj][m][1]; const int c = pn * 256 + bj * 128 + cin;
                    if (pn < 12 || (pn >= 21 && pn < 28)) { u32x4 w; w.x = pg8::cvt_pk_bf16(v0[0], v0[1]); w.y = pg8::cvt_pk_bf16(v0[2], v0[3]); w.z = pg8::cvt_pk_bf16(v1[0], v1[1]); w.w = pg8::cvt_pk_bf16(v1[2], v1[3]);
                        *(u32x4*)(UA + row * UALD + (pn < 12 ? c : c - 2304)) = w; }
                    else if (pn < 21) { float* q = UM + row * UMLD + (c - 3072); *(f32x4*)q = v0; *(f32x4*)(q + 4) = v1; }
                    else if (bj == 0 && wc == 0) { float* q = UG + row * 32 + cin; *(f32x4*)q = v0; *(f32x4*)(q + 4) = v1; }
                }
            }
    }
};
struct EpiRes {
    static constexpr bool PERM = false, AFTER_DRAIN = false;
    const bf16_t* X; bf16_t* Z; int ld; float s;
    __device__ __forceinline__ void operator()(const f32x4 (&acc)[2][2][4][2], const pg8::Unit& u, int wr, int wc, int fr, int fq) const {
        const int row0 = u.pm * 256 + wr * 64 + fr, col0 = u.pn * 256 + wc * 32 + 4 * fq;
#pragma unroll
        for (int ai = 0; ai < 2; ++ai)
#pragma unroll
            for (int m = 0; m < 4; ++m) {
                const size_t off = (size_t)(row0 + ai * 128 + m * 16) * ld + col0;
#pragma unroll
                for (int bj = 0; bj < 2; ++bj)
#pragma unroll
                    for (int n = 0; n < 2; ++n) { const u32x2 xw = *(const u32x2*)(X + off + bj * 128 + n * 16);
                        const f32x4 xv = (f32x4){bf_lo(xw.x), bf_hi(xw.x), bf_lo(xw.y), bf_hi(xw.y)}, r = xv * ALPHA + acc[ai][bj][m][n] * s;
                        u32x2 w; w.x = pg8::cvt_pk_bf16(r[0], r[1]); w.y = pg8::cvt_pk_bf16(r[2], r[3]); *(u32x2*)(Z + off + bj * 128 + n * 16) = w; }
                asm volatile("" ::: "memory");
            }
    }
};

constexpr int KS_FFN = 4, KS_OUT = 4, KS_MAX = 4;
struct EpiPart {
    static constexpr bool PERM = false, AFTER_DRAIN = false;
    float* P;
    __device__ __forceinline__ void operator()(const f32x4 (&acc)[2][2][4][2], const pg8::Unit& u, int wr, int wc, int fr, int fq) const {
        const int row0 = u.pm * 256 + wr * 64 + fr, col0 = u.pn * 256 + wc * 32 + 4 * fq; float* base = P + (size_t)u.ks * MS * D;
#pragma unroll
        for (int ai = 0; ai < 2; ++ai)
#pragma unroll
            for (int m = 0; m < 4; ++m) {
                float* rowp = base + (size_t)(row0 + ai * 128 + m * 16) * D + col0;
#pragma unroll
                for (int bj = 0; bj < 2; ++bj)
#pragma unroll
                    for (int n = 0; n < 2; ++n) *(f32x4*)(rowp + bj * 128 + n * 16) = acc[ai][bj][m][n];
            }
    }
};
struct ResOrder : pg8::StaticOrder {
    int nks, ntsub, ksub_bytes;
    __device__ __forceinline__ bool next(int i, pg8::Unit& u) const {
        const long L = (long)i * G + c;
        if (L < nwg) { map((int)L, u); return true; }
        const int j = (int)(L - nwg); if (j >= 16 * nks) return false;
        const int t = (nks == KS_OUT) ? j / KS_OUT : j / KS_FFN;
        u.ks = j - t * nks; u.pm = (MP / 256) + (t >> 3); u.pn = t & 7; u.koff = u.ks * ksub_bytes; u.nt = ntsub; return true;
    }
};
struct EpiResPart {
    static constexpr bool PERM = false, AFTER_DRAIN = false;
    EpiRes r; EpiPart q;
    __device__ __forceinline__ void operator()(const f32x4 (&acc)[2][2][4][2], const pg8::Unit& u, int wr, int wc, int fr, int fq) const {
        if (u.pm < MP / 256) r(acc, u, wr, wc, fr, fq);
        else { pg8::Unit v = u; v.pm = u.pm - MP / 256; q(acc, v, wr, wc, fr, fq); }
    }
};
template <int MODE> __device__ __forceinline__ int map_row(int n) {
    if (MODE == 0) return n;
    if (MODE == 1) return 256 * (n >> 7) + (n & 127);
    if (MODE == 2) return 256 * (n >> 7) + 128 + (n & 127);
    if (n < 3072) return n;
    if (n < 3078) return UGB + (n - 3072);
    if (n < 3084) return UGA + (n - 3078);
    if (n < 6156) return n - 12;
    if (n < 6162) return UMI + (n - 6156);
    if (n < 6168) return UMF + (n - 6162);
    return n - 24;
}
constexpr int CT_LD = 260;
template <int MODE> __device__ __forceinline__ void convert_w(const float* __restrict__ W, int K, int N, bf16_t* __restrict__ Bt, float* tile, int t_begin, int t_end, int t_step) {
    const int tid = otid(), ntn = (N + 255) >> 8, ntiles = ntn * (K >> 6); if (t_end > ntiles) t_end = ntiles;
    for (int t = t_begin; t < t_end; t += t_step) {
        const int tk = t / ntn, tn = t - tk * ntn, k0 = tk * 64, n0 = tn * 256;
        { const int wv = tid >> 6, ln = tid & 63, n = n0 + ln * 4;
          f32x4 v[8];
#pragma unroll
          for (int i = 0; i < 8; ++i) v[i] = (n < N) ? __builtin_nontemporal_load((const f32x4*)(W + (size_t)(k0 + wv + 8 * i) * N + n)) : (f32x4){0.f, 0.f, 0.f, 0.f};
#pragma unroll
          for (int i = 0; i < 8; ++i) *(f32x4*)(tile + (wv + 8 * i) * CT_LD + ln * 4) = v[i]; }
        __syncthreads();
        { const int nn = tid & 255, kh = tid >> 8, n = n0 + nn;
          if (n < N) { const float* tp = tile + (kh * 32) * CT_LD + nn; bf16_t* dst = Bt + (size_t)map_row<MODE>(n) * K + k0 + kh * 32;
#pragma unroll
              for (int q = 0; q < 4; ++q) { u32x4 w;
                  w.x = pg8::cvt_pk_bf16(tp[(8 * q + 0) * CT_LD], tp[(8 * q + 1) * CT_LD]); w.y = pg8::cvt_pk_bf16(tp[(8 * q + 2) * CT_LD], tp[(8 * q + 3) * CT_LD]);
                  w.z = pg8::cvt_pk_bf16(tp[(8 * q + 4) * CT_LD], tp[(8 * q + 5) * CT_LD]); w.w = pg8::cvt_pk_bf16(tp[(8 * q + 6) * CT_LD], tp[(8 * q + 7) * CT_LD]);
                  *(u32x4*)(dst + 8 * q) = w; } } }
        __syncthreads();
    }
}
__device__ __forceinline__ void phase_convert(const Params& p, int d, float* lds) {
    unsigned char* ws = ows(p);
    const int b0 = obid(), G = gridDim.x;
    if (d == 0) {
        convert_w<1>(p.in[9], D, DFF, (bf16_t*)(ws + WS_WGU1), lds, b0, 1 << 30, G);
        convert_w<2>(p.in[10], D, DFF, (bf16_t*)(ws + WS_WGU1), lds, b0, 1 << 30, G);
        convert_w<0>(p.in[11], DFF, D, (bf16_t*)(ws + WS_WD1), lds, b0, 1 << 30, G);
    }
    const size_t gt = (size_t)obid() * 512 + otid(), gn = (size_t)gridDim.x * 512;
    if (d == 0) {
        u32x4* zp = (u32x4*)((bf16_t*)(ws + WS_WIN) + (size_t)DIN * D);
        for (size_t i = gt; i < (size_t)(DINP - DIN) * D / 8; i += gn) zp[i] = (u32x4){0u, 0u, 0u, 0u};
        bf16_t* XB = (bf16_t*)(ws + WS_XB);
        for (size_t i = gt; i < (size_t)M * D / 4; i += gn) {
            const f32x4 v = (i < (size_t)MP * D / 4) ? __builtin_nontemporal_load((const f32x4*)p.in[0] + i) : __builtin_nontemporal_load((const f32x4*)p.in[1] + (i - (size_t)MP * D / 4));
            u32x2 w; w.x = pg8::cvt_pk_bf16(v[0], v[1]); w.y = pg8::cvt_pk_bf16(v[2], v[3]); ((u32x2*)XB)[i] = w;
        }
    }
}

__device__ __forceinline__ void phase_ln(const bf16_t* Z, const bf16_t* XBold, const float* PART, int nks, float sres, const float* __restrict__ g, const float* __restrict__ b, float* OUTF, bf16_t* XB) {
    const int tid = otid(), lane = tid & 63, gw = obid() * 8 + (tid >> 6), nw = gridDim.x * 8;
    for (int row = gw; row < M; row += nw) {
        float v[4][8]; float s = 0.f;
#pragma unroll
        for (int i = 0; i < 4; ++i) {
            const int c8 = lane + 64 * i;
            const u32x4 w = ((const u32x4*)((row < MP ? Z : XBold) + (size_t)row * D))[c8];
            v[i][0] = bf_lo(w.x); v[i][1] = bf_hi(w.x); v[i][2] = bf_lo(w.y); v[i][3] = bf_hi(w.y); v[i][4] = bf_lo(w.z); v[i][5] = bf_hi(w.z); v[i][6] = bf_lo(w.w); v[i][7] = bf_hi(w.w);
            if (row >= MP) {
                const f32x4* pp = (const f32x4*)PART + (size_t)(row - MP) * (D / 4) + 2 * c8;
#pragma unroll
                for (int hh = 0; hh < 2; ++hh) { f32x4 ps = pp[hh];
                    for (int q = 1; q < nks; ++q) ps += pp[hh + (size_t)q * (MS * D / 4)];
#pragma unroll
                    for (int j = 0; j < 4; ++j) v[i][hh * 4 + j] = v[i][hh * 4 + j] * ALPHA + ps[j] * sres; }
            }
#pragma unroll
            for (int j = 0; j < 8; ++j) s += v[i][j];
        }
        s = reduce64(s); const float mu = s * (1.0f / D); float q = 0.f;
#pragma unroll
        for (int i = 0; i < 4; ++i)
#pragma unroll
            for (int j = 0; j < 8; ++j) { const float dd = v[i][j] - mu; q = fmaf(dd, dd, q); }
        q = reduce64(q); const float rs = rsqrtf(q * (1.0f / D) + EPS);
#pragma unroll
        for (int i = 0; i < 4; ++i) {
            const int c8 = lane + 64 * i; const f32x4 g0 = ((const f32x4*)g)[2 * c8], g1 = ((const f32x4*)g)[2 * c8 + 1], b0 = ((const f32x4*)b)[2 * c8], b1 = ((const f32x4*)b)[2 * c8 + 1];
            float o[8];
#pragma unroll
            for (int j = 0; j < 4; ++j) { o[j] = (v[i][j] - mu) * rs * g0[j] + b0[j]; o[4 + j] = (v[i][4 + j] - mu) * rs * g1[j] + b1[j]; }
            u32x4 w; w.x = pg8::cvt_pk_bf16(o[0], o[1]); w.y = pg8::cvt_pk_bf16(o[2], o[3]); w.z = pg8::cvt_pk_bf16(o[4], o[5]); w.w = pg8::cvt_pk_bf16(o[6], o[7]);
            ((u32x4*)(XB + (size_t)row * D))[c8] = w;
            if (OUTF) { ((f32x4*)(OUTF + (size_t)row * D))[2 * c8] = (f32x4){o[0], o[1], o[2], o[3]}; ((f32x4*)(OUTF + (size_t)row * D))[2 * c8 + 1] = (f32x4){o[4], o[5], o[6], o[7]}; }
        }
    }
}

struct RowInfo { int prompt, t, b, T; };
__device__ __forceinline__ RowInfo row_info(int r) { RowInfo ri; ri.prompt = r < MP; if (ri.prompt) { ri.t = r & (SEQ - 1); ri.b = r >> 11; ri.T = SEQ; } else { ri.t = (r - MP) & 3; ri.b = (r - MP) >> 2; ri.T = ST; } return ri; }
constexpr int TG = 17, NGRP = M / TG;
__device__ __forceinline__ void phase_prep(const Params& p, int d, float* lds) {
    unsigned char* ws = ows(p); const int tid = otid();
    const bf16_t* UA = (const bf16_t*)(ws + WS_BIG); const float* UG = (const float*)(ws + WS_BIG + WS_UG_OFF);
    float* GQ = (float*)(ws + WS_GQ); float* GK = (float*)(ws + WS_GK); float* GV = (float*)(ws + WS_GV);
    float* LA = (float*)(ws + WS_LA); float* LU = (float*)(ws + WS_LU);
    float* SCB = (float*)(ws + WS_SC); float* SCE = SCB + (size_t)M * 8; float* SCI = SCE + (size_t)M * 8; float* SCF = SCI + (size_t)M * 8;
    const float* gcw = p.in[15] + (size_t)d * 4 * GCONV; const float* A_log = p.in[16] + d * NH; const float* dtb = p.in[17] + d * NH;
    const float* ibias = p.in[19] + d * NH; const float* fbias = p.in[20] + d * NH;
    const float* lcw = p.in[22] + (size_t)d * 4 * LW; const float* lcb = p.in[23] + (size_t)d * LW;
    const float* wr = p.in[24] + (size_t)d * 8 * 64 * 64; const float* br = p.in[25] + (size_t)d * LW; const float* wi = p.in[26] + (size_t)d * 8 * 64 * 64; const float* bi = p.in[27] + (size_t)d * LW;
    const float* lam = p.in[28] + (size_t)d * LW;
    const float* sgc = p.in[3] + (size_t)d * SBAT * 3 * GCONV; const float* slc = p.in[8] + (size_t)d * SBAT * 3 * LW;
    float* o_pgc = p.out + O_PGC + (size_t)d * NB * 3 * GCONV; float* o_sgc = p.out + O_SGC + (size_t)d * SBAT * 3 * GCONV;
    float* o_plc = p.out + O_PLC + (size_t)d * NB * 3 * LW; float* o_slc = p.out + O_SLC + (size_t)d * SBAT * 3 * LW;
    float* cx = lds;
    for (int grp = obid(); grp < NGRP; grp += gridDim.x) {
        const int r0 = grp * TG;
        for (int it = 0; it < (TG * 576 + 511) / 512; it += 4) {
            f32x4 x3[4], xl[4][3], cw[4][4]; int rr[4], cc[4]; bool ok[4];
#pragma unroll
            for (int uu = 0; uu < 4; ++uu) {
                const int idx0 = tid + 512 * (it + uu); ok[uu] = idx0 < TG * 576; const int idx = ok[uu] ? idx0 : tid;
                const int tok = idx / 576, c = (idx - tok * 576) * 4, r = r0 + tok; const RowInfo ri = row_info(r); rr[uu] = r; cc[uu] = c;
                x3[uu] = ld_bf4(UA + (size_t)r * UALD + c);
#pragma unroll
                for (int L = 1; L <= 3; ++L) {
                    f32x4 v;
                    if (ri.t - L >= 0) v = ld_bf4(UA + (size_t)(r - L) * UALD + c);
                    else if (ri.prompt) v = (f32x4){0.f, 0.f, 0.f, 0.f};
                    else v = *(const f32x4*)(sgc + ((size_t)ri.b * 3 + (3 + ri.t - L)) * GCONV + c);
                    xl[uu][L - 1] = v;
                }
#pragma unroll
                for (int j = 0; j < 4; ++j) cw[uu][j] = *(const f32x4*)(gcw + j * GCONV + c);
            }
#pragma unroll
            for (int uu = 0; uu < 4; ++uu) {
                const int r = rr[uu], c = cc[uu]; const RowInfo ri = row_info(r);
                f32x4 y = cw[uu][0] * xl[uu][2] + cw[uu][1] * xl[uu][1] + cw[uu][2] * xl[uu][0] + cw[uu][3] * x3[uu];
#pragma unroll
                for (int j = 0; j < 4; ++j) y[j] = siluf_(y[j]);
                float ss = (y[0] * y[0] + y[1] * y[1]) + (y[2] * y[2] + y[3] * y[3]);
                ss = reduce32(ss);
                if (ok[uu]) {
                    if (c < QK) { *(f32x4*)(GQ + (size_t)r * QK + c) = y * (rsqrtf(ss + EPS) * 0.08838834764831845f); }
                    else if (c < 2 * QK) { *(f32x4*)(GK + (size_t)r * QK + (c - QK)) = y * rsqrtf(ss + EPS); }
                    else { *(f32x4*)(GV + (size_t)r * QK + (c - 2 * QK)) = y; }
                    if (ri.t >= ri.T - 3) { const int j = ri.t - (ri.T - 3); float* dst = ri.prompt ? o_pgc : o_sgc; *(f32x4*)(dst + ((size_t)ri.b * 3 + j) * GCONV + c) = x3[uu]; }
                }
            }
        }
        if (tid < TG * NH) {
            const int tok = tid / NH, h = tid - tok * NH, r = r0 + tok; const float* ur = UG + (size_t)r * 32 - UGB;
            const float beta = sigmoidf_(ur[UGB + h]);
            const float g = -expf(A_log[h]) * softplusf_(ur[UGA + h] + dtb[h]);
            SCB[(size_t)r * 8 + h] = beta; SCE[(size_t)r * 8 + h] = expf(g);
            SCI[(size_t)r * 8 + h] = ur[UMI + h] + ibias[h];
            SCF[(size_t)r * 8 + h] = -softplusf_(-(ur[UMF + h] + fbias[h]));
        }
        for (int idx = tid; idx < TG * 128; idx += 512) {
            const int tok = idx >> 7, c = (idx & 127) * 4, r = r0 + tok; const RowInfo ri = row_info(r);
            const f32x4 z4 = (f32x4){0.f, 0.f, 0.f, 0.f};
            const f32x4 x3 = ld_bf4(UA + (size_t)r * UALD + ALX + c);
            f32x4 xl[3];
#pragma unroll
            for (int L = 1; L <= 3; ++L) {
                f32x4 v;
                if (ri.t - L >= 0) v = ld_bf4(UA + (size_t)(r - L) * UALD + ALX + c);
                else if (ri.prompt) v = z4;
                else v = *(const f32x4*)(slc + ((size_t)ri.b * 3 + (3 + ri.t - L)) * LW + c);
                xl[L - 1] = v;
            }
            const f32x4 w0 = *(const f32x4*)(lcw + c), w1 = *(const f32x4*)(lcw + LW + c), w2 = *(const f32x4*)(lcw + 2 * LW + c), w3 = *(const f32x4*)(lcw + 3 * LW + c);
            const f32x4 y = w0 * xl[2] + w1 * xl[1] + w2 * xl[0] + w3 * x3 + *(const f32x4*)(lcb + c);
            *(f32x4*)(cx + tok * LW + c) = y;
            if (ri.t >= ri.T - 3) { const int j = ri.t - (ri.T - 3); float* dst = ri.prompt ? o_plc : o_slc; *(f32x4*)(dst + ((size_t)ri.b * 3 + j) * LW + c) = x3; }
        }
        __syncthreads();
        {
            int co = tid; asm volatile("" : "+v"(co));
            const int c = co, blk = c >> 6, e = c & 63;
            AS1 const float* wrp = (AS1 const float*)wr + (size_t)blk * 4096 + e; AS1 const float* wip = (AS1 const float*)wi + (size_t)blk * 4096 + e; const float* cxb = cx + blk * 64;
            f32x2v w2[64];
#pragma unroll
            for (int dd = 0; dd < 64; ++dd) { w2[dd][0] = wrp[dd * 64]; w2[dd][1] = wip[dd * 64]; }
            const float brv = br[c], biv = bi[c], spl = softplusf_(-lam[c]);
#pragma unroll 1
            for (int k = 0; k < TG; ++k) {
                f32x2v a0 = (f32x2v){0.f, 0.f}, a1 = a0, a2 = a0, a3 = a0;
#pragma unroll
                for (int hq = 0; hq < 2; ++hq) {
                f32x4 xv[16];
#pragma unroll
                for (int q = hq * 8; q < hq * 8 + 8; ++q) xv[q] = *(const f32x4*)(cxb + k * LW + q * 4);
#pragma unroll
                for (int q = hq * 8; q < hq * 8 + 8; ++q) { a0 = __builtin_elementwise_fma((f32x2v){xv[q][0], xv[q][0]}, w2[4 * q], a0); a1 = __builtin_elementwise_fma((f32x2v){xv[q][1], xv[q][1]}, w2[4 * q + 1], a1);
                    a2 = __builtin_elementwise_fma((f32x2v){xv[q][2], xv[q][2]}, w2[4 * q + 2], a2); a3 = __builtin_elementwise_fma((f32x2v){xv[q][3], xv[q][3]}, w2[4 * q + 3], a3); }
                }
                const f32x2v at = (a0 + a1) + (a2 + a3);
                const int r = r0 + k;
                const float rg = sigmoidf_(at[0] + brv), ig = sigmoidf_(at[1] + biv);
                const float log_a = -8.0f * rg * spl;
                LA[(size_t)r * LW + c] = __expf(log_a);
                LU[(size_t)r * LW + c] = __builtin_amdgcn_sqrtf(fmaxf(1.0f - __expf(2.0f * log_a), 0.f)) * (ig * cx[k * LW + c]);
            }
        }
        __syncthreads();
    }
}

template <int NC> struct GTok { f32x4 k0, k1, q0, q1; float v[NC]; float a, b; };
template <int NC> __device__ __forceinline__ void tok_load(GTok<NC>& t, const float* kp, const float* qp, const float* vp, const float* ap, const float* bp) {
    t.k0 = *(const f32x4*)kp; t.k1 = *(const f32x4*)(kp + 4); t.q0 = *(const f32x4*)qp; t.q1 = *(const f32x4*)(qp + 4);
    if (NC == 4) { const f32x4 vv = *(const f32x4*)vp; t.v[0] = vv[0]; t.v[NC > 1 ? 1 : 0] = vv[1]; t.v[NC > 2 ? 2 : 0] = vv[2]; t.v[NC > 3 ? 3 : 0] = vv[3]; }
    else {
#pragma unroll
        for (int j = 0; j < NC; ++j) t.v[j] = vp[j];
    }
    t.a = *ap; t.b = *bp;
}
template <int NC, bool NT = false> __device__ __forceinline__ void store_nc(float* dst, const float (&o)[NC]) {
    if (NC == 4) { if (NT) __builtin_nontemporal_store((f32x4){o[0], o[NC > 1 ? 1 : 0], o[NC > 2 ? 2 : 0], o[NC > 3 ? 3 : 0]}, (f32x4*)dst); else *(f32x4*)dst = (f32x4){o[0], o[NC > 1 ? 1 : 0], o[NC > 2 ? 2 : 0], o[NC > 3 ? 3 : 0]}; }
    else {
#pragma unroll
        for (int j = 0; j < NC; ++j) dst[j] = o[j];
    }
}
template <int NC> __device__ __forceinline__ void gdn_step(float (&S)[8][NC], const GTok<NC>& t, float* orow, bool writer) {
    const float kk[8] = {t.k0[0], t.k0[1], t.k0[2], t.k0[3], t.k1[0], t.k1[1], t.k1[2], t.k1[3]};
    const float qq[8] = {t.q0[0], t.q0[1], t.q0[2], t.q0[3], t.q1[0], t.q1[1], t.q1[2], t.q1[3]};
    float u[NC], o[NC];
#pragma unroll
    for (int j = 0; j < NC; ++j) { float r = 0.f;
#pragma unroll
        for (int i = 0; i < 8; ++i) r = fmaf(S[i][j], kk[i], r);
        r = allreduce16(r); u[j] = t.a * (t.v[j] - t.b * r); }
#pragma unroll
    for (int j = 0; j < NC; ++j) { float a = 0.f;
#pragma unroll
        for (int i = 0; i < 8; ++i) { S[i][j] = fmaf(kk[i], u[j], t.b * S[i][j]); a = fmaf(S[i][j], qq[i], a); }
        o[j] = allreduce16(a); }
    if (writer) store_nc<NC>(orow, o);
}
template <int NC> __device__ __forceinline__ void mls_step(float (&C)[8][NC], float (&n)[8], float& m, const GTok<NC>& t, float* orow, bool writer) {
    const float kk[8] = {t.k0[0], t.k0[1], t.k0[2], t.k0[3], t.k1[0], t.k1[1], t.k1[2], t.k1[3]};
    const float qq[8] = {t.q0[0], t.q0[1], t.q0[2], t.q0[3], t.q1[0], t.q1[1], t.q1[2], t.q1[3]};
    const float mn = fmaxf(t.b + m, t.a), fd = expf(t.b + m - mn), iw = expf(t.a - mn) * 0.08838834764831845f; m = mn;
    float den = 0.f, kw[8];
#pragma unroll
    for (int i = 0; i < 8; ++i) { kw[i] = iw * kk[i]; n[i] = fmaf(fd, n[i], kw[i]); den = fmaf(n[i], qq[i], den); }
    den = allreduce16(den);
    const float inv = 1.0f / fmaxf(fabsf(den), expf(-mn));
    float o[NC];
#pragma unroll
    for (int j = 0; j < NC; ++j) { float a = 0.f;
#pragma unroll
        for (int i = 0; i < 8; ++i) { C[i][j] = fmaf(kw[i], t.v[j], fd * C[i][j]); a = fmaf(C[i][j], qq[i], a); }
        o[j] = allreduce16(a) * inv; }
    if (writer) store_nc<NC>(orow, o);
}

template <int NC, int KIND> __device__ __forceinline__ void mixer_item(const Params& p, int d, int prompt, int b, int h, int slab, int lane) {
    unsigned char* ws = ows(p);
    const int ks = lane & 15, cl = lane >> 4, cb = slab * (4 * NC) + cl * NC;
    const int T = prompt ? SEQ : ST, rbase = prompt ? b * SEQ : MP + b * ST;
    const float *kp, *qp, *vp, *ap, *bp; size_t kstride;
    if (KIND == 0) { kp = (const float*)(ws + WS_GK) + (size_t)rbase * QK + h * HD + 8 * ks; qp = (const float*)(ws + WS_GQ) + (size_t)rbase * QK + h * HD + 8 * ks; vp = (const float*)(ws + WS_GV) + (size_t)rbase * QK + h * HD + cb; kstride = QK;
        ap = (const float*)(ws + WS_SC) + (size_t)rbase * 8 + h; bp = ap + (size_t)M * 8; }
    else { const float* U = (const float*)(ws + WS_BIG + WS_UM_OFF) + (size_t)rbase * UMLD; kp = U + QK + h * HD + 8 * ks; qp = U + h * HD + 8 * ks; vp = U + 2 * QK + h * HD + cb; kstride = UMLD;
        ap = (const float*)(ws + WS_SC) + (size_t)2 * M * 8 + (size_t)rbase * 8 + h; bp = ap + (size_t)M * 8; }
    float* orow = (float*)(ws + WS_Z) + (size_t)rbase * D + (KIND == 0 ? 0 : QK) + h * HD + cb;
    const int nbatch = prompt ? NB : SBAT;
    const size_t sidx = ((size_t)(d * nbatch + b) * NH + h);
    float S[8][NC], n[8], m = 0.f;
#pragma unroll
    for (int i = 0; i < 8; ++i) { n[i] = 0.f;
#pragma unroll
        for (int j = 0; j < NC; ++j) S[i][j] = 0.f; }
    if (!prompt) {
        const float* S0 = p.in[KIND == 0 ? 2 : 4] + sidx * HD * HD + (size_t)(8 * ks) * HD + cb;
#pragma unroll
        for (int i = 0; i < 8; ++i) {
            if (NC == 4) { const f32x4 v = __builtin_nontemporal_load((const f32x4*)(S0 + i * HD)); S[i][0] = v[0]; S[i][NC > 1 ? 1 : 0] = v[1]; S[i][NC > 2 ? 2 : 0] = v[2]; S[i][NC > 3 ? 3 : 0] = v[3]; }
            else {
#pragma unroll
                for (int j = 0; j < NC; ++j) S[i][j] = S0[i * HD + j];
            }
        }
        if (KIND == 1) {
            const float* n0 = p.in[5] + sidx * HD + 8 * ks;
#pragma unroll
            for (int i = 0; i < 8; ++i) n[i] = n0[i];
            m = p.in[6][sidx];
        }
    }
    const bool writer = (ks == 0);
    GTok<NC> A[4], B[4];
    const int nblk = T >> 2;
#define LOADBLK(buf, blk) do { _Pragma("unroll") for (int q_ = 0; q_ < 4; ++q_) { const size_t t_ = (size_t)(blk) * 4 + q_; tok_load<NC>(buf[q_], kp + t_ * kstride, qp + t_ * kstride, vp + t_ * kstride, ap + t_ * 8, bp + t_ * 8); } } while (0)
#define COMPBLK(buf, blk) do { _Pragma("unroll") for (int q_ = 0; q_ < 4; ++q_) { const size_t t_ = (size_t)(blk) * 4 + q_; \
        if (KIND == 0) gdn_step<NC>(S, buf[q_], orow + t_ * D, writer); else mls_step<NC>(S, n, m, buf[q_], orow + t_ * D, writer); } } while (0)
    LOADBLK(A, 0);
    for (int blk = 0; blk < nblk; blk += 2) {
        if (blk + 1 < nblk) LOADBLK(B, blk + 1);
        COMPBLK(A, blk);
        if (blk + 1 < nblk) {
            if (blk + 2 < nblk) LOADBLK(A, blk + 2);
            COMPBLK(B, blk + 1);
        }
    }
#undef LOADBLK
#undef COMPBLK
    float* So = p.out + (KIND == 0 ? (prompt ? O_PGS : O_SGS) : (prompt ? O_PMC : O_SMC)) + sidx * HD * HD + (size_t)(8 * ks) * HD + cb;
#pragma unroll
    for (int i = 0; i < 8; ++i) { float tmp[NC];
#pragma unroll
        for (int j = 0; j < NC; ++j) tmp[j] = S[i][j];
        store_nc<NC, true>(So + i * HD, tmp); }
    if (KIND == 1 && slab == 0) {
        if (cl == 0) { float* no = p.out + (prompt ? O_PMN : O_SMN) + sidx * HD + 8 * ks;
#pragma unroll
            for (int i = 0; i < 8; ++i) no[i] = n[i]; }
        if (lane == 0) p.out[(prompt ? O_PMM : O_SMM) + sidx] = m;
    }
}
__device__ __forceinline__ void lru_item(const Params& p, int d, int prompt, int b, int grp, int lane) {
    unsigned char* ws = ows(p);
    const int c = grp * 64 + lane, T = prompt ? SEQ : ST, rbase = prompt ? b * SEQ : MP + b * ST;
    const float* la = (const float*)(ws + WS_LA) + (size_t)rbase * LW + c; const float* lu = (const float*)(ws + WS_LU) + (size_t)rbase * LW + c;
    float* orow = (float*)(ws + WS_Z) + (size_t)rbase * D + 2 * QK + c;
    float hst = prompt ? 0.f : p.in[7][((size_t)d * SBAT + b) * LW + c];
    for (int t = 0; t < T; t += 4) {
        float a[4], u[4];
#pragma unroll
        for (int q = 0; q < 4; ++q) { a[q] = la[(size_t)(t + q) * LW]; u[q] = lu[(size_t)(t + q) * LW]; }
#pragma unroll
        for (int q = 0; q < 4; ++q) { hst = fmaf(a[q], hst, u[q]); orow[(size_t)(t + q) * D] = hst; }
    }
    p.out[(prompt ? O_PLH : O_SLH) + ((size_t)d * (prompt ? NB : SBAT) + b) * LW + c] = hst;
}
constexpr int TCH = 32, LB_K = 0, LB_Q = TCH * 128, LB_V = 2 * TCH * 128, LB_AB = LB_V + TCH * 32, LB_SZ = LB_AB + TCH * 2, LB_ITEM = 2 * LB_SZ;
template <int CTRL> __device__ __forceinline__ float updpp(float oldv, float x) { return __builtin_bit_cast(float, __builtin_amdgcn_update_dpp(__builtin_bit_cast(int, oldv), __builtin_bit_cast(int, x), CTRL, 0xf, 0xf, false)); }
__device__ __forceinline__ float rdlane(float v, int l) { return __builtin_bit_cast(float, __builtin_amdgcn_readlane(__builtin_bit_cast(int, v), l)); }
template <int KIND> __device__ __forceinline__ void prompt_item(const Params& p, int d, int b, int h, int sg, float* lds) {
    unsigned char* ws = ows(p);
    const int tid = otid(), wave = tid >> 6, lane = tid & 63, ks = lane & 15, cl = lane >> 4, col = sg * 32 + wave * 4 + cl;
    const int rbase = b * SEQ;
    const float *kg, *qg, *vg, *ag, *bg; size_t kstride;
    if (KIND == 0) { kg = (const float*)(ws + WS_GK) + (size_t)rbase * QK + h * HD; qg = (const float*)(ws + WS_GQ) + (size_t)rbase * QK + h * HD; vg = (const float*)(ws + WS_GV) + (size_t)rbase * QK + h * HD + sg * 32; kstride = QK;
        ag = (const float*)(ws + WS_SC) + (size_t)rbase * 8 + h; bg = ag + (size_t)M * 8; }
    else { const float* U = (const float*)(ws + WS_BIG + WS_UM_OFF) + (size_t)rbase * UMLD; kg = U + QK + h * HD; qg = U + h * HD; vg = U + 2 * QK + h * HD + sg * 32; kstride = UMLD;
        ag = (const float*)(ws + WS_SC) + (size_t)2 * M * 8 + (size_t)rbase * 8 + h; bg = ag + (size_t)M * 8; }
    float* og = (float*)(ws + WS_Z) + (size_t)rbase * D + (KIND == 0 ? 0 : QK) + h * HD + col;
    AS1 const float *kG = (AS1 const float*)kg, *qG = (AS1 const float*)qg, *vG = (AS1 const float*)vg, *aG = (AS1 const float*)ag, *bG = (AS1 const float*)bg; AS1 float* oG = (AS1 float*)og;
    const int lt0 = tid >> 5, lf4 = tid & 31;
    const int lds_kq = (lf4 & 1) * 16 + (lf4 >> 1);
    const int vt = tid >> 3, vf4 = tid & 7;
    const int at = tid >> 1, aw = tid & 1;
    f32x4 kr0, kr1, qr0, qr1, vr; float abr = 0.f;
    vr = (f32x4){0.f, 0.f, 0.f, 0.f};
#define PI_LOAD(c) do { const size_t t0_ = (size_t)(c) * TCH; \
        kr0 = *(AS1 const f32x4*)(kG + (t0_ + lt0) * kstride + lf4 * 4); kr1 = *(AS1 const f32x4*)(kG + (t0_ + lt0 + 16) * kstride + lf4 * 4); \
        qr0 = *(AS1 const f32x4*)(qG + (t0_ + lt0) * kstride + lf4 * 4); qr1 = *(AS1 const f32x4*)(qG + (t0_ + lt0 + 16) * kstride + lf4 * 4); \
        if (tid < 256) vr = *(AS1 const f32x4*)(vG + (t0_ + vt) * kstride + vf4 * 4); \
        if (tid < 64) abr = (aw ? bG : aG)[(t0_ + at) * 8]; } while (0)
#define PI_STORE(buf) do { float* b_ = lds + (buf) * LB_SZ; \
        ((f32x4*)(b_ + LB_K))[lt0 * 32 + lds_kq] = kr0; ((f32x4*)(b_ + LB_K))[(lt0 + 16) * 32 + lds_kq] = kr1; \
        ((f32x4*)(b_ + LB_Q))[lt0 * 32 + lds_kq] = qr0; ((f32x4*)(b_ + LB_Q))[(lt0 + 16) * 32 + lds_kq] = qr1; \
        if (tid < 256) ((f32x4*)(b_ + LB_V))[vt * 8 + vf4] = vr; \
        if (tid < 64) b_[LB_AB + at * 2 + aw] = abr; } while (0)
    f32x2v S2[4], n2[4]; float mcar = 0.f;
#pragma unroll
    for (int i = 0; i < 4; ++i) { S2[i] = (f32x2v){0.f, 0.f}; n2[i] = (f32x2v){0.f, 0.f}; }
    const bool writer = (ks == 0);
    __syncthreads();
    PI_LOAD(0); PI_STORE(0);
    __syncthreads();
    constexpr int NCH = SEQ / TCH;
    for (int c = 0; c < NCH; ++c) {
        if (c + 1 < NCH) PI_LOAD(c + 1);
        const float* bf = lds + (c & 1) * LB_SZ;
        const int tl = lane & 31;
        float ga = bf[LB_AB + tl * 2], gb = bf[LB_AB + tl * 2 + 1], gc = 0.f;
        if (KIND == 1) {
            const float ip = ga, lf = gb;
            float cs = lf;
            cs += updpp<0x111>(0.f, cs); cs += updpp<0x112>(0.f, cs); cs += updpp<0x114>(0.f, cs); cs += updpp<0x118>(0.f, cs);
            { const float r0 = rdlane(cs, 15); if (lane & 16) cs += r0; }
            float pm = ip - cs;
            const float NINF = -3.0e38f;
            pm = fmaxf(pm, updpp<0x111>(NINF, pm)); pm = fmaxf(pm, updpp<0x112>(NINF, pm)); pm = fmaxf(pm, updpp<0x114>(NINF, pm)); pm = fmaxf(pm, updpp<0x118>(NINF, pm));
            { const float r0 = rdlane(pm, 15); if (lane & 16) pm = fmaxf(pm, r0); }
            const float mt = cs + fmaxf(mcar, pm);
            float mprev = updpp<0x111>(0.f, mt); { const float r0 = rdlane(mt, 15); if ((lane & 31) == 16) mprev = r0; }
            if (tl == 0) mprev = mcar;
            ga = __expf(lf + mprev - mt);
            gb = __expf(ip - mt) * 0.08838834764831845f;
            gc = __expf(-mt);
            mcar = rdlane(mt, 31);
        }
        AS1 float* orow = oG + (size_t)c * TCH * D;
        const f32x4* kb4 = (const f32x4*)(bf + LB_K) + ks; const f32x4* qb4 = (const f32x4*)(bf + LB_Q) + ks; const float* vb1 = bf + LB_V + wave * 4 + cl;
        f32x4 nk0 = kb4[0], nk1 = kb4[16], nq0 = qb4[0], nq1 = qb4[16]; float nv = vb1[0];
#pragma unroll 4
        for (int tt = 0; tt < TCH; ++tt) {
            const f32x4 k0 = nk0, k1 = nk1, q0 = nq0, q1 = nq1; const float v = nv;
            { const int tn = (tt + 1 < TCH) ? tt + 1 : tt;
              nk0 = kb4[tn * 32]; nk1 = kb4[tn * 32 + 16]; nq0 = qb4[tn * 32]; nq1 = qb4[tn * 32 + 16]; nv = vb1[tn * 32]; }
            const f32x2v k2[4] = {(f32x2v){k0[0], k0[1]}, (f32x2v){k0[2], k0[3]}, (f32x2v){k1[0], k1[1]}, (f32x2v){k1[2], k1[3]}};
            const f32x2v q2[4] = {(f32x2v){q0[0], q0[1]}, (f32x2v){q0[2], q0[3]}, (f32x2v){q1[0], q1[1]}, (f32x2v){q1[2], q1[3]}};
            const float sa = rdlane(ga, tt), sb = rdlane(gb, tt);
            if (KIND == 0) {
                f32x2v r2 = S2[0] * k2[0];
#pragma unroll
                for (int i = 1; i < 4; ++i) r2 = __builtin_elementwise_fma(S2[i], k2[i], r2);
                const float r = allreduce16(r2[0] + r2[1]);
                const float u = sa * (v - sb * r);
                f32x2v o2 = (f32x2v){0.f, 0.f};
#pragma unroll
                for (int i = 0; i < 4; ++i) { S2[i] = __builtin_elementwise_fma(S2[i], (f32x2v){sb, sb}, k2[i] * u); o2 = __builtin_elementwise_fma(S2[i], q2[i], o2); }
                const float o = allreduce16(o2[0] + o2[1]);
                orow[(size_t)tt * D] = o;
            } else {
                const float vs = v * sb;
                f32x2v o2 = (f32x2v){0.f, 0.f};
#pragma unroll
                for (int i = 0; i < 4; ++i) { S2[i] = __builtin_elementwise_fma(k2[i], (f32x2v){vs, vs}, S2[i] * sa); o2 = __builtin_elementwise_fma(S2[i], q2[i], o2); }
                const float num = allreduce16(o2[0] + o2[1]);
                orow[(size_t)tt * D] = num;
            }
        }
        if (c + 1 < NCH) PI_STORE((c + 1) & 1);
        __syncthreads();
    }
#undef PI_LOAD
#undef PI_STORE
    const size_t sidx = ((size_t)(d * NB + b) * NH + h);
    float* So = p.out + (KIND == 0 ? O_PGS : O_PMC) + sidx * HD * HD + (size_t)(8 * ks) * HD + col;
#pragma unroll
    for (int i = 0; i < 4; ++i) { So[(2 * i) * HD] = S2[i][0]; So[(2 * i + 1) * HD] = S2[i][1]; }
}
__device__ __forceinline__ void lru_prompt_item(const Params& p, int d, int b) {
    unsigned char* ws = ows(p);
    const int c = otid(), rbase = b * SEQ;
    const float* la = (const float*)(ws + WS_LA) + (size_t)rbase * LW + c; const float* lu = (const float*)(ws + WS_LU) + (size_t)rbase * LW + c;
    float* orow = (float*)(ws + WS_Z) + (size_t)rbase * D + 2 * QK + c;
    float hst = 0.f;
    constexpr int LB = 32, NBLK = SEQ / LB;
    float aA[LB], uA[LB], aB[LB], uB[LB];
#define LR_LOAD(a_, u_, blk) do { _Pragma("unroll") for (int q_ = 0; q_ < LB; ++q_) { a_[q_] = la[(size_t)((blk) * LB + q_) * LW]; u_[q_] = lu[(size_t)((blk) * LB + q_) * LW]; } } while (0)
#define LR_COMP(a_, u_, blk) do { _Pragma("unroll") for (int q_ = 0; q_ < LB; ++q_) { hst = fmaf(a_[q_], hst, u_[q_]); orow[(size_t)((blk) * LB + q_) * D] = hst; } } while (0)
    LR_LOAD(aA, uA, 0);
    for (int blk = 0; blk < NBLK; blk += 2) {
        LR_LOAD(aB, uB, blk + 1);
        LR_COMP(aA, uA, blk);
        if (blk + 2 < NBLK) LR_LOAD(aA, uA, blk + 2);
        LR_COMP(aB, uB, blk + 1);
    }
#undef LR_LOAD
#undef LR_COMP
    p.out[O_PLH + ((size_t)d * NB + b) * LW + c] = hst;
}
__device__ __forceinline__ void mden_item(const Params& p, int d, int b, int h, int lane) {
    unsigned char* ws = ows(p);
    const int rbase = b * SEQ, tl = lane & 31;
    AS1 const float* U = (AS1 const float*)((const float*)(ws + WS_BIG + WS_UM_OFF) + (size_t)rbase * UMLD);
    AS1 const float* kp = U + QK + h * HD + 2 * lane; AS1 const float* qp = U + h * HD + 2 * lane;
    AS1 const float* ipp = (AS1 const float*)((const float*)(ws + WS_SC) + (size_t)2 * M * 8 + (size_t)rbase * 8 + h); AS1 const float* lfp = ipp + (size_t)M * 8;
    AS1 float* deno = (AS1 float*)((float*)(ws + WS_SC) + (size_t)4 * M * 8 + (size_t)rbase * 8 + h); AS1 float* emo = deno + (size_t)M * 8;
    f32x2v n2 = (f32x2v){0.f, 0.f}; float mcar = 0.f, ga = 0.f, gb = 0.f;
    f32x2v kA[16], qA[16], kB[16], qB[16];
    constexpr int NHALF = SEQ / 16;
#define MD_LOAD(kk_, qq_, hh_) do { _Pragma("unroll") for (int j_ = 0; j_ < 16; ++j_) { const size_t t_ = (size_t)(hh_) * 16 + j_; kk_[j_] = *(AS1 const f32x2v*)(kp + t_ * UMLD); qq_[j_] = *(AS1 const f32x2v*)(qp + t_ * UMLD); } } while (0)
#define MD_COMP(kk_, qq_, hh_) do { float dv_ = 0.f; const int tb_ = ((hh_) & 1) * 16; \
        _Pragma("unroll") for (int j_ = 0; j_ < 16; ++j_) { const float sa_ = rdlane(ga, tb_ + j_), sb_ = rdlane(gb, tb_ + j_); \
            n2 = __builtin_elementwise_fma(n2, (f32x2v){sa_, sa_}, kk_[j_] * sb_); const f32x2v pr_ = n2 * qq_[j_]; \
            const float s_ = allreduce16(pr_[0] + pr_[1]); const float tot_ = (rdlane(s_, 0) + rdlane(s_, 16)) + (rdlane(s_, 32) + rdlane(s_, 48)); dv_ = (lane == j_) ? tot_ : dv_; } \
        if (lane < 16) deno[((size_t)(hh_) * 16 + lane) * 8] = dv_; } while (0)
#define MD_GATES(cc_) do { const float ip_ = ipn, lf_ = lfn; if ((cc_) + 1 < SEQ / 32) { ipn = ipp[((size_t)((cc_) + 1) * 32 + tl) * 8]; lfn = lfp[((size_t)((cc_) + 1) * 32 + tl) * 8]; } \
        float cs_ = lf_; cs_ += updpp<0x111>(0.f, cs_); cs_ += updpp<0x112>(0.f, cs_); cs_ += updpp<0x114>(0.f, cs_); cs_ += updpp<0x118>(0.f, cs_); \
        { const float r0_ = rdlane(cs_, 15); if (lane & 16) cs_ += r0_; } \
        float pm_ = ip_ - cs_; const float NI_ = -3.0e38f; \
        pm_ = fmaxf(pm_, updpp<0x111>(NI_, pm_)); pm_ = fmaxf(pm_, updpp<0x112>(NI_, pm_)); pm_ = fmaxf(pm_, updpp<0x114>(NI_, pm_)); pm_ = fmaxf(pm_, updpp<0x118>(NI_, pm_)); \
        { const float r0_ = rdlane(pm_, 15); if (lane & 16) pm_ = fmaxf(pm_, r0_); } \
        const float mt_ = cs_ + fmaxf(mcar, pm_); float mp_ = updpp<0x111>(0.f, mt_); { const float r0_ = rdlane(mt_, 15); if (tl == 16) mp_ = r0_; } if (tl == 0) mp_ = mcar; \
        ga = __expf(lf_ + mp_ - mt_); gb = __expf(ip_ - mt_) * 0.08838834764831845f; \
        if (lane < 32) emo[((size_t)(cc_) * 32 + tl) * 8] = __expf(-mt_); mcar = rdlane(mt_, 31); } while (0)
    float ipn = ipp[(size_t)tl * 8], lfn = lfp[(size_t)tl * 8];
    MD_LOAD(kA, qA, 0);
    for (int hh = 0; hh < NHALF; hh += 2) {
        MD_LOAD(kB, qB, hh + 1);
        MD_GATES(hh >> 1);
        MD_COMP(kA, qA, hh);
        if (hh + 2 < NHALF) MD_LOAD(kA, qA, hh + 2);
        MD_COMP(kB, qB, hh + 1);
    }
#undef MD_LOAD
#undef MD_COMP
#undef MD_GATES
    const size_t sidx = ((size_t)(d * NB + b) * NH + h);
    *(f32x2v*)(p.out + O_PMN + sidx * HD + 2 * lane) = n2;
    if (lane == 0) p.out[O_PMM + sidx] = mcar;
}
constexpr int CVT = 4, CV_OUT = (D / 256) * (D / 64) / CVT, CV_FF = (DFF / 256) * (D / 64) / CVT, CV_FD = (D / 256) * (DFF / 64) / CVT, CV_THIS = CV_OUT + 2 * CV_FF + CV_FD, CV_NEXT = 2 * CV_FF;
__device__ __forceinline__ void cv_item(const Params& p, int d, int j, float* lds) {
    unsigned char* ws = ows(p);
    __syncthreads();
    if (j < CV_OUT) { convert_w<0>(p.in[29] + (size_t)d * D * D, D, D, (bf16_t*)(ws + WS_WOUT), lds, j * CVT, j * CVT + CVT, 1); return; }
    j -= CV_OUT;
    if (j < CV_FF) { convert_w<1>(p.in[30] + (size_t)d * D * DFF, D, DFF, (bf16_t*)(ws + WS_WGU2), lds, j * CVT, j * CVT + CVT, 1); return; }
    j -= CV_FF;
    if (j < CV_FF) { convert_w<2>(p.in[31] + (size_t)d * D * DFF, D, DFF, (bf16_t*)(ws + WS_WGU2), lds, j * CVT, j * CVT + CVT, 1); return; }
    j -= CV_FF;
    if (j < CV_FD) { convert_w<0>(p.in[32] + (size_t)d * DFF * D, DFF, D, (bf16_t*)(ws + WS_WD2), lds, j * CVT, j * CVT + CVT, 1); return; }
    j -= CV_FD;
    if (j < CV_FF) { convert_w<1>(p.in[9] + (size_t)(d + 1) * D * DFF, D, DFF, (bf16_t*)(ws + WS_WGU1), lds, j * CVT, j * CVT + CVT, 1); return; }
    j -= CV_FF;
    convert_w<2>(p.in[10] + (size_t)(d + 1) * D * DFF, D, DFF, (bf16_t*)(ws + WS_WGU1), lds, j * CVT, j * CVT + CVT, 1);
}
constexpr int IT_DN = 0, IT_GP = IT_DN + NB * NH / 8, IT_MP = IT_GP + NB * NH * 4, IT_LP = IT_MP + NB * NH * 4, IT_GS = IT_LP + NB, IT_MS = IT_GS + SBAT * NH, IT_LS = IT_MS + SBAT * NH, IT_END = IT_LS + SBAT;
__device__ __forceinline__ void phase_scan(const Params& p, int d, int rep, float* lds, int it_lo, int it_hi) {
    unsigned* ctr = (unsigned*)(ows(p) + WS_CTL) + 64 * (1 + d + 2 * rep);
    const int tid = otid(), lane = tid & 63, wave = tid >> 6;
    unsigned* slot = (unsigned*)(lds + LB_ITEM);
    for (;;) {
        __syncthreads();
        if (tid == 0) *slot = atomicAdd(ctr, 1u);
        __syncthreads();
        const unsigned it = (unsigned)__builtin_amdgcn_readfirstlane((int)*slot) + (unsigned)it_lo;
        if (it >= (unsigned)it_hi) break;
        if (it < (unsigned)IT_GP) { const int bh = it * 8 + wave; mden_item(p, d, bh / NH, bh % NH, lane); }
        else if (it < (unsigned)IT_MP) { const int x = it - IT_GP, bh = x >> 2; prompt_item<0>(p, d, bh / NH, bh % NH, x & 3, lds); }
        else if (it < (unsigned)IT_LP) { const int x = it - IT_MP, bh = x >> 2; prompt_item<1>(p, d, bh / NH, bh % NH, x & 3, lds); }
        else if (it < (unsigned)IT_GS) { lru_prompt_item(p, d, it - IT_LP); }
        else if (it < (unsigned)IT_MS) { const int bh = it - IT_GS; mixer_item<4, 0>(p, d, 0, bh / NH, bh % NH, wave, lane); }
        else if (it < (unsigned)IT_LS) { const int bh = it - IT_MS; mixer_item<4, 1>(p, d, 0, bh / NH, bh % NH, wave, lane); }
        else if (it < (unsigned)IT_END) { lru_item(p, d, 0, it - IT_LS, wave, lane); }
        else { cv_item(p, d, (int)it - IT_END, lds); }
    }
}

__device__ __forceinline__ float gelu_tanh(float y) { const float z = 0.7978845608028654f * (y + 0.044715f * y * y * y); return y * __builtin_amdgcn_rcpf(1.0f + __expf(-2.0f * z)); }
__device__ __forceinline__ void phase_post(const Params& p, int d) {
    unsigned char* ws = ows(p);
    const bf16_t* UA = (const bf16_t*)(ws + WS_BIG); const float* OR = (const float*)(ws + WS_Z); bf16_t* MIX = (bf16_t*)(ws + WS_MIX);
    const float* gnw = p.in[18] + (size_t)d * HD; const float* mnw = p.in[21] + (size_t)d * QK;
    const int tid = otid(), lane = tid & 63, gw = obid() * 8 + (tid >> 6), nw = gridDim.x * 8;
    for (int row = gw; row < M; row += nw) {
        const float* orow = OR + (size_t)row * D; const bf16_t* ur = UA + (size_t)row * UALD; bf16_t* mrow = MIX + (size_t)row * D;
#pragma unroll
        for (int i = 0; i < 3; ++i) {
            const int c = (lane + 64 * i) * 4;
            const f32x4 o = *(const f32x4*)(orow + c); float ss = (o[0] * o[0] + o[1] * o[1]) + (o[2] * o[2] + o[3] * o[3]); ss = reduce32(ss);
            const float rs = rsqrtf(ss * (1.0f / HD) + EPS); const f32x4 w = *(const f32x4*)(gnw + (c & 127)), z = ld_bf4(ur + AZ + c);
            float r[4];
#pragma unroll
            for (int j = 0; j < 4; ++j) r[j] = o[j] * rs * w[j] * siluf_(z[j]);
            u32x2 pk; pk.x = pg8::cvt_pk_bf16(r[0], r[1]); pk.y = pg8::cvt_pk_bf16(r[2], r[3]); *(u32x2*)(mrow + c) = pk;
        }
#pragma unroll
        for (int i = 0; i < 3; ++i) {
            const int c = (lane + 64 * i) * 4;
            f32x4 o = *(const f32x4*)(orow + QK + c);
            if (row < MP) { const float* scd = (const float*)(ws + WS_SC) + (size_t)4 * M * 8 + (size_t)row * 8 + (c >> 7); o = o * __builtin_amdgcn_rcpf(fmaxf(fabsf(scd[0]), scd[(size_t)M * 8])); }
            float ss = (o[0] * o[0] + o[1] * o[1]) + (o[2] * o[2] + o[3] * o[3]); ss = reduce32(ss);
            const float rs = rsqrtf(ss * (1.0f / HD) + EPS); const f32x4 w = *(const f32x4*)(mnw + c), z = ld_bf4(ur + AMO + c);
            float r[4];
#pragma unroll
            for (int j = 0; j < 4; ++j) r[j] = o[j] * rs * w[j] * sigmoidf_(z[j]);
            u32x2 pk; pk.x = pg8::cvt_pk_bf16(r[0], r[1]); pk.y = pg8::cvt_pk_bf16(r[2], r[3]); *(u32x2*)(mrow + QK + c) = pk;
        }
#pragma unroll
        for (int i = 0; i < 2; ++i) {
            const int c = (lane + 64 * i) * 4;
            const f32x4 o = *(const f32x4*)(orow + 2 * QK + c), y = ld_bf4(ur + ALY + c);
            float r[4];
#pragma unroll
            for (int j = 0; j < 4; ++j) r[j] = o[j] * gelu_tanh(y[j]);
            u32x2 pk; pk.x = pg8::cvt_pk_bf16(r[0], r[1]); pk.y = pg8::cvt_pk_bf16(r[2], r[3]); *(u32x2*)(mrow + 2 * QK + c) = pk;
        }
    }
}

#define XB_TMO      128
#define XB_XCNT(j)  (256  + 64 * (j))
#define XB_XSUB(j)  (1280 + 64 * (j))
#define XB_XGEN(j)  (2304 + 64 * (j))
#define XB_TOP      3328
#define XB_TOPGEN   3392
#define XCD_BAR_WORDS 3456
#define XB_SPIN_CAP (1u << 18)
#ifndef LAS
#define LAS __attribute__((address_space(3)))
#endif

__device__ __forceinline__ unsigned xb_ld(unsigned* p)              { return __hip_atomic_load(p, __ATOMIC_RELAXED, __HIP_MEMORY_SCOPE_AGENT); }
__device__ __forceinline__ unsigned xb_add(unsigned* p, unsigned v) { return __hip_atomic_fetch_add(p, v, __ATOMIC_RELAXED, __HIP_MEMORY_SCOPE_AGENT); }
__device__ __forceinline__ unsigned xb_xcc_id() { return (unsigned)__builtin_amdgcn_s_getreg((3 << 11) | 20) & 0xFu; }
#define XB_SPIN(cond, bar) do { unsigned _sp = 0; while (cond) { __builtin_amdgcn_s_sleep(1); \
    if ((++_sp & 255u) == 0u) { if (xb_ld(&(bar)[XB_TMO])) break; if (_sp > XB_SPIN_CAP) { atomicAdd(&(bar)[XB_TMO], 1u); break; } } } } while (0)

struct XcdBarrier {
    unsigned* bar; unsigned x;
    volatile LAS unsigned* st;
};

__device__ __forceinline__ XcdBarrier xcd_barrier_post(unsigned* bar, volatile LAS unsigned* st) {
    XcdBarrier b; b.bar = bar; b.x = xb_xcc_id(); b.st = st;
    if (threadIdx.x == 0) (void)xb_add(&bar[XB_XCNT(b.x)], 1u);
    return b;
}
__device__ __forceinline__ void xcd_barrier_complete(unsigned* bar, unsigned x, unsigned& nloc, unsigned& nx) {
    const unsigned G = gridDim.x * gridDim.y * gridDim.z;
    unsigned sum, cnt, mine, sp = 0u;
    for (;;) {
        sum = 0u; cnt = 0u; mine = 0u;
#pragma unroll
        for (unsigned j = 0; j < 16; ++j) { const unsigned c = xb_ld(&bar[XB_XCNT(j)]); sum += c; cnt += (c > 0u) ? 1u : 0u; mine = (j == x) ? c : mine; }
        if (sum == G) break;
        __builtin_amdgcn_s_sleep(1);
        if ((++sp & 255u) == 0u) { if (xb_ld(&bar[XB_TMO])) break; if (sp > XB_SPIN_CAP) { atomicAdd(&bar[XB_TMO], 1u); break; } }
    }
    nloc = mine > 0u ? mine : 1u; nx = cnt > 0u ? cnt : 1u;
}

__device__ __forceinline__ void xcd_barrier(const XcdBarrier& b) {
    asm volatile("s_waitcnt vmcnt(0)" ::: "memory");
    __syncthreads();
    if (threadIdx.x == 0) {
        unsigned* bar = b.bar;
        __builtin_amdgcn_s_waitcnt(0);
        unsigned nloc = b.st[0], nx = b.st[1];
        if (nloc == 0u) { xcd_barrier_complete(bar, b.x, nloc, nx); b.st[0] = nloc; b.st[1] = nx; }
        const unsigned old = xb_add(&bar[XB_XSUB(b.x)], 1u);
        const unsigned gen = old / nloc;
        if (old + 1u == (gen + 1u) * nloc) {
            __builtin_amdgcn_fence(__ATOMIC_RELEASE, "agent");
            asm volatile("s_waitcnt vmcnt(0)" ::: "memory");
            const unsigned og = xb_add(&bar[XB_TOP], 1u);
            const unsigned tg = og / nx;
            if (og + 1u == (tg + 1u) * nx) xb_add(&bar[XB_TOPGEN], 1u);
            else XB_SPIN(xb_ld(&bar[XB_TOPGEN]) == tg, bar);
            __builtin_amdgcn_fence(__ATOMIC_ACQUIRE, "agent");
            xb_add(&bar[XB_XGEN(b.x)], 1u);
            asm volatile("s_waitcnt vmcnt(0)" ::: "memory");
        } else {
            XB_SPIN(xb_ld(&bar[XB_XGEN(b.x)]) == gen, bar);
            __builtin_amdgcn_fence(__ATOMIC_ACQUIRE, "agent");
            asm volatile("s_waitcnt vmcnt(0)" ::: "memory");
        }
    }
    __syncthreads();
}
constexpr int LDS_BYTES = pg8::STAGE_BYTES + 16;
__global__ void __launch_bounds__(512) hybrid_fwd(Params p) {
    extern __shared__ __attribute__((aligned(16))) unsigned char lds[];
    cg::grid_group grid = cg::this_grid();
    volatile LAS unsigned* xst = (volatile LAS unsigned*)((LAS unsigned char*)lds + pg8::STAGE_BYTES);
    if (threadIdx.x == 0) { xst[0] = 0u; xst[1] = 0u; }
    __syncthreads();
    XcdBarrier xbar = xcd_barrier_post((unsigned*)(p.ws + WS_BAR), xst);
    for (int ph = p.ph_lo; ph < p.ph_hi; ++ph) {
        unsigned char* ws = ows(p);
        bf16_t* XB = (bf16_t*)(ws + WS_XB); bf16_t* Z = (bf16_t*)(ws + WS_Z);
        bf16_t* HB = (bf16_t*)(ws + WS_BIG); bf16_t* MIX = (bf16_t*)(ws + WS_MIX);
        const int d = ph / NPH_LAYER, s = ph - d * NPH_LAYER;
        if (s == 0 && d > 0) continue;
        const float* lng = p.in[12] + (size_t)d * 3 * D; const float* lnb = p.in[13] + (size_t)d * 3 * D;
#ifndef DBL_MASK
#define DBL_MASK 0
#endif
        for (int rep = 0; rep < (((DBL_MASK >> s) & 1) ? 2 : 1); ++rep) {
        if (rep) grid.sync();
        switch (s) {
        case 0: phase_convert(p, d, (float*)lds); break;
        case 1: case 10: {
            pg8::Gemm g{XB, (const bf16_t*)(ws + (s == 1 ? WS_WGU1 : WS_WGU2)), M, NGU, D, D}; pg8::StaticOrder S; S.init(M, NGU, gridDim.x, obid(), D);
            EpiSwiglu E{HB, DFF}; pg8::gemm_phase<EpiSwiglu, pg8::StaticOrder, false>((PG8_LAS unsigned char*)lds, g, S, E, nullptr); break; }
        case 2: case 8: case 11: {
            const bf16_t* A = (s == 8) ? MIX : HB; const bf16_t* Bt = (const bf16_t*)(ws + (s == 2 ? WS_WD1 : (s == 8 ? WS_WOUT : WS_WD2)));
            const int Kf = (s == 8) ? D : DFF, nks = (s == 8) ? KS_OUT : KS_FFN, Ksub = (s == 8) ? D / KS_OUT : DFF / KS_FFN;
            pg8::Gemm g{A, Bt, MP, D, Kf, Kf}; ResOrder S; S.init(MP, D, gridDim.x, obid(), Kf); S.nks = nks; S.ntsub = Ksub / 64; S.ksub_bytes = Ksub * 2;
            EpiResPart E{EpiRes{XB, Z, D, (s == 8) ? 1.0f : 0.5f}, EpiPart{(float*)(ws + WS_PART)}};
            pg8::gemm_phase<EpiResPart, ResOrder, false>((PG8_LAS unsigned char*)lds, g, S, E, nullptr);
            if (s == 2) {
                const int nsub = 16 * KS_FFN, b0 = obid(), G = gridDim.x;
                if (G > nsub) { if (b0 >= nsub) convert_w<3>(p.in[14] + (size_t)d * D * DIN, D, DIN, (bf16_t*)(ws + WS_WIN), (float*)lds, b0 - nsub, 1 << 30, G - nsub); }
                else convert_w<3>(p.in[14] + (size_t)d * D * DIN, D, DIN, (bf16_t*)(ws + WS_WIN), (float*)lds, b0, 1 << 30, G);
            }
            if (s == 11 && d + 1 < DEPTH) {
                const int nsub = 16 * KS_FFN, b0 = obid(), G = gridDim.x;
                if (G > nsub) { if (b0 >= nsub) convert_w<0>(p.in[11] + (size_t)(d + 1) * DFF * D, DFF, D, (bf16_t*)(ws + WS_WD1), (float*)lds, b0 - nsub, 1 << 30, G - nsub); }
                else convert_w<0>(p.in[11] + (size_t)(d + 1) * DFF * D, DFF, D, (bf16_t*)(ws + WS_WD1), (float*)lds, b0, 1 << 30, G);
            }
            break; }
        case 3: case 9: case 12: {
            const int li = (s == 3) ? 0 : (s == 9 ? 1 : 2);
            float* dst = (s == 12 && d == DEPTH - 1) ? p.out : nullptr;
            phase_ln(Z, XB, (const float*)(ws + WS_PART), (s == 9) ? KS_OUT : KS_FFN, (s == 9) ? 1.0f : 0.5f, lng + li * D, lnb + li * D, dst, XB); break; }
        case 4: {
            pg8::Gemm g{XB, (const bf16_t*)(ws + WS_WIN), M, DINP, D, D}; pg8::StaticOrder S; S.init(M, DINP, gridDim.x, obid(), D);
            EpiU E{(bf16_t*)(ws + WS_BIG), (float*)(ws + WS_BIG + WS_UM_OFF), (float*)(ws + WS_BIG + WS_UG_OFF)}; pg8::gemm_phase<EpiU, pg8::StaticOrder, false>((PG8_LAS unsigned char*)lds, g, S, E, nullptr); break; }
        case 5: phase_prep(p, d, (float*)lds); break;
        #ifndef SCAN_PROBE
#define SCAN_PROBE 0
#endif
        case 6: phase_scan(p, d, 0, (float*)lds, 0, IT_END + CV_THIS + (d + 1 < DEPTH ? CV_NEXT : 0));
            if (SCAN_PROBE == 1) { grid.sync(); phase_scan(p, d, 1, (float*)lds, 0, IT_LP); }
            if (SCAN_PROBE == 2) { grid.sync(); phase_scan(p, d, 1, (float*)lds, IT_GS, IT_END); }
            if (SCAN_PROBE == 3) { grid.sync(); phase_scan(p, d, 1, (float*)lds, IT_LP, IT_GS); }
            break;
        case 7: phase_post(p, d); break;
        }
        }
        if (ph + 1 < p.ph_hi) { if (p.ph_hi < 0) grid.sync(); else xcd_barrier(xbar); }
    }
}

extern "C" void kernel_launch(void* const* d_in, const int* in_sizes, int n_in, void* d_out, int out_size, void* d_ws, size_t ws_size, hipStream_t stream) {
    static int grid = 0;
    if (grid == 0) {
        if (n_in != 33 || (size_t)out_size != O_END || ws_size < WS_END) { fprintf(stderr, "kernel_launch: unexpected shapes: n_in %d out %d ws %zu (need %zu / %zu)\n", n_in, out_size, ws_size, (size_t)O_END, (size_t)WS_END); grid = -1; return; }
        int dev = 0, cus = 0, per_cu = 0;
        hipGetDevice(&dev); hipDeviceGetAttribute(&cus, hipDeviceAttributeMultiprocessorCount, dev);
        if (hipFuncSetAttribute((const void*)hybrid_fwd, hipFuncAttributeMaxDynamicSharedMemorySize, LDS_BYTES) != hipSuccess) { fprintf(stderr, "kernel_launch: hipFuncSetAttribute failed\n"); grid = -1; return; }
        if (hipOccupancyMaxActiveBlocksPerMultiprocessor(&per_cu, (const void*)hybrid_fwd, 512, LDS_BYTES) != hipSuccess || per_cu < 1) { fprintf(stderr, "kernel_launch: occupancy query says %d\n", per_cu); per_cu = 1; }
        (void)hipGetLastError();
        grid = cus * 1;
        if (grid <= 0) grid = 256;
    }
    if (grid < 0) return;
    (void)hipMemsetAsync((char*)d_ws + WS_CTL, 0, 32768, stream);
    Params p{};
    for (int i = 0; i < 33; ++i) p.in[i] = (const float*)d_in[i];
    p.out = (float*)d_out; p.ws = (unsigned char*)d_ws;
#if MULTI_LAUNCH
    for (int ph = 0; ph < NPH; ++ph) { p.ph_lo = ph; p.ph_hi = ph + 1; hipLaunchKernelGGL(hybrid_fwd, dim3(grid), dim3(512), LDS_BYTES, stream, p); }
#else
    p.ph_lo = 0; p.ph_hi = NPH;
    void* args[] = {&p};
    hipError_t e = hipLaunchCooperativeKernel((const void*)hybrid_fwd, dim3(grid), dim3(512), args, LDS_BYTES, stream);
    if (e != hipSuccess) fprintf(stderr, "cooperative launch failed: %s (grid %d)\n", hipGetErrorString(e), grid);
#endif
}
```
